# Optimizing an MI355X kernel written in HIP

```python
import jax, jax.numpy as jnp
from jax import lax
import numpy as np

D_MODEL = 1024
BATCH = 4
SEQ = 8192
DEPTH = 1

CHUNK = 64
MIX_WIDTH = D_MODEL
HGRN_WIDTH = MIX_WIDTH // 2
HGRN_HEAD_DIM = 128
HGRN_HEADS = HGRN_WIDTH // HGRN_HEAD_DIM
POOL_WIDTH = MIX_WIDTH - HGRN_WIDTH
POOL_WINDOWS = (2, 4, 8, 16)
N_POOL_GROUPS = len(POOL_WINDOWS)
POOL_GW = POOL_WIDTH // N_POOL_GROUPS
IN_COLS = 4 * HGRN_WIDTH + POOL_WIDTH
N_EXPERTS = 32
TOP_K = 4
D_FF = D_MODEL
SWIGLU_LIMIT = 7.0
SWIGLU_ALPHA = 1.702
EXPERT_BLOCK = 256
NORM_EPS = 1e-6

kernel_name = 'hybrid_hgrn2_pool_moe'


def rmsnorm(x, g):
    xf = x.astype(jnp.float32)
    y = xf * lax.rsqrt(jnp.mean(xf * xf, axis=-1, keepdims=True) + NORM_EPS)
    return (y * g.astype(jnp.float32)).astype(x.dtype)


def hgrn2(q_pre, f_pre, v, g_pre, lb, norm_g):
    B_, S_, _ = q_pre.shape
    n_chunks = S_ // CHUNK
    q = jax.nn.silu(q_pre.astype(jnp.float32))
    f = lb + (1.0 - lb) * jax.nn.sigmoid(f_pre.astype(jnp.float32))
    log_f = jnp.log(f)
    k = 1.0 - f

    def to_chunks(a):
        a = a.astype(jnp.float32).reshape(B_, n_chunks, CHUNK, HGRN_HEADS, HGRN_HEAD_DIM)
        return a.transpose(1, 0, 3, 2, 4)

    causal = jnp.tril(jnp.ones((CHUNK, CHUNK), dtype=bool))

    def step(state, inp):
        qc, kc, vc, lfc = inp
        b = jnp.cumsum(lfc, axis=2)
        b_last = b[:, :, -1, :]
        o_inter = jnp.einsum('bhtk,bhkv->bhtv', qc * jnp.exp(b), state)
        diff = b[:, :, :, None, :] - b[:, :, None, :, :]
        decay = jnp.exp(jnp.where(causal[None, None, :, :, None], diff, -jnp.inf))
        scores = jnp.einsum('bhtk,bhtsk,bhsk->bhts', qc, decay, kc)
        o = o_inter + jnp.einsum('bhts,bhsv->bhtv', scores, vc)
        new_state = jnp.exp(b_last)[..., None] * state + jnp.einsum(
            'bhsk,bhsv->bhkv', kc * jnp.exp(b_last[:, :, None, :] - b), vc)
        return new_state, o

    state0 = jnp.zeros((B_, HGRN_HEADS, HGRN_HEAD_DIM, HGRN_HEAD_DIM), jnp.float32)
    _, o = lax.scan(step, state0, (to_chunks(q), to_chunks(k), to_chunks(v), to_chunks(log_f)))
    o = o.transpose(1, 0, 3, 2, 4).reshape(B_, S_, HGRN_HEADS, HGRN_HEAD_DIM)
    o = o * lax.rsqrt(jnp.mean(o * o, axis=-1, keepdims=True) + NORM_EPS) * norm_g.astype(jnp.float32)
    gate = jax.nn.silu(g_pre.astype(jnp.float32)).reshape(B_, S_, HGRN_HEADS, HGRN_HEAD_DIM)
    return (o * gate).reshape(B_, S_, HGRN_WIDTH).astype(q_pre.dtype)


def pool_mixer(u, w, scale):
    B_, S_, _ = u.shape
    ug = u.astype(jnp.float32).reshape(B_, S_, N_POOL_GROUPS, POOL_GW)
    cs = jnp.cumsum(ug, axis=1)
    pos = jnp.arange(1, S_ + 1, dtype=jnp.float32)[None, :, None]
    outs = []
    for gi, win in enumerate(POOL_WINDOWS):
        c = cs[:, :, gi, :]
        lower = jnp.pad(c, ((0, 0), (win, 0), (0, 0)))[:, :S_]
        mean = (c - lower) / jnp.minimum(pos, float(win))
        outs.append(mean - ug[:, :, gi, :])
    d = jnp.stack(outs, axis=2)
    y = jnp.einsum('bsgc,gcd->bsgd', d, w.astype(jnp.float32))
    return (y.reshape(B_, S_, POOL_WIDTH) * scale.astype(jnp.float32)).astype(u.dtype)


def moe(h, w_r, b_r, w_g, b_g, w_u, b_u, w_d, b_d):
    B_, S_, D = h.shape
    N = B_ * S_
    t = h.reshape(N, D)
    logits = (t @ w_r + b_r).astype(jnp.float32)
    top_logit, top_e = lax.top_k(logits, TOP_K)
    gate = jax.nn.softmax(top_logit, axis=-1)
    M = N * TOP_K
    e_flat = top_e.reshape(M)
    order = jnp.argsort(e_flat)
    e_sorted = e_flat[order]
    tok_sorted = (order // TOP_K).astype(jnp.int32)
    gate_sorted = gate.reshape(M)[order]
    counts = jnp.bincount(e_flat, length=N_EXPERTS)
    start = jnp.cumsum(counts) - counts
    padded = (counts + EXPERT_BLOCK - 1) // EXPERT_BLOCK * EXPERT_BLOCK
    pad_end = jnp.cumsum(padded)
    pad_start = pad_end - padded
    dest = pad_start[e_sorted] + (jnp.arange(M) - start[e_sorted])
    P = M + N_EXPERTS * EXPERT_BLOCK
    n_blocks = P // EXPERT_BLOCK
    row_tok = jnp.full((P,), N, jnp.int32).at[dest].set(tok_sorted)
    row_gate = jnp.zeros((P,), jnp.float32).at[dest].set(gate_sorted)
    blk_e = jnp.minimum(jnp.searchsorted(pad_end, jnp.arange(n_blocks) * EXPERT_BLOCK, side='right'),
                        N_EXPERTS - 1)
    t_pad = jnp.concatenate([t, jnp.zeros((1, D), t.dtype)], axis=0)
    xs = t_pad[row_tok].reshape(n_blocks, EXPERT_BLOCK, D)

    def expert_block(args):
        xb, e = args
        gt = jnp.minimum(xb @ w_g[e] + b_g[e], SWIGLU_LIMIT)
        up = jnp.clip(xb @ w_u[e] + b_u[e], -SWIGLU_LIMIT, SWIGLU_LIMIT)
        act = (up + 1.0) * (gt * jax.nn.sigmoid(SWIGLU_ALPHA * gt))
        return act @ w_d[e] + b_d[e]

    ys = lax.map(expert_block, (xs, blk_e)).reshape(P, D)
    ys = ys * row_gate.astype(ys.dtype)[:, None]
    out = jax.ops.segment_sum(ys, row_tok, num_segments=N + 1)[:N]
    return out.reshape(B_, S_, D)


def setup_inputs(seed: int = 0) -> dict:
    key = jax.random.key(seed)
    ks = jax.random.split(key, 20)

    def nrm(k, shape, scale):
        return jax.random.normal(k, shape, jnp.float32) * scale

    return {
        'x': nrm(ks[0], (BATCH, SEQ, D_MODEL), 1.0),
        'norm1_g': 1.0 + nrm(ks[1], (DEPTH, D_MODEL), 0.02),
        'w_in': nrm(ks[2], (DEPTH, D_MODEL, IN_COLS), D_MODEL ** -0.5),
        'hgrn_lb': nrm(ks[3], (DEPTH + 1, HGRN_WIDTH), 0.5),
        'hgrn_norm_g': 1.0 + nrm(ks[4], (DEPTH, HGRN_HEAD_DIM), 0.02),
        'pool_w': nrm(ks[5], (DEPTH, N_POOL_GROUPS, POOL_GW, POOL_GW), POOL_GW ** -0.5),
        'pool_scale': 1.0 + nrm(ks[6], (DEPTH, POOL_WIDTH), 0.02),
        'w_out': nrm(ks[7], (DEPTH, MIX_WIDTH, D_MODEL), MIX_WIDTH ** -0.5),
        'norm2_g': 1.0 + nrm(ks[8], (DEPTH, D_MODEL), 0.02),
        'router_w': nrm(ks[9], (DEPTH, D_MODEL, N_EXPERTS), D_MODEL ** -0.5),
        'router_b': nrm(ks[10], (DEPTH, N_EXPERTS), 0.01),
        'w_gate': nrm(ks[11], (DEPTH, N_EXPERTS, D_MODEL, D_FF), D_MODEL ** -0.5),
        'b_gate': nrm(ks[12], (DEPTH, N_EXPERTS, D_FF), 0.01),
        'w_up': nrm(ks[13], (DEPTH, N_EXPERTS, D_MODEL, D_FF), D_MODEL ** -0.5),
        'b_up': nrm(ks[14], (DEPTH, N_EXPERTS, D_FF), 0.01),
        'w_down': nrm(ks[15], (DEPTH, N_EXPERTS, D_FF, D_MODEL), D_FF ** -0.5),
        'b_down': nrm(ks[16], (DEPTH, N_EXPERTS, D_MODEL), 0.01),
        'norm_f_g': 1.0 + nrm(ks[17], (D_MODEL,), 0.02),
    }


def reference(x, norm1_g, w_in, hgrn_lb, hgrn_norm_g, pool_w, pool_scale, w_out, norm2_g,
              router_w, router_b, w_gate, b_gate, w_up, b_up, w_down, b_down, norm_f_g):
    lb_all = jnp.cumsum(jax.nn.softmax(hgrn_lb.astype(jnp.float32), axis=0), axis=0)
    split_at = [HGRN_WIDTH, 2 * HGRN_WIDTH, 3 * HGRN_WIDTH, 4 * HGRN_WIDTH]
    for l in range(DEPTH):
        h = rmsnorm(x, norm1_g[l])
        proj = h @ w_in[l]
        q_pre, f_pre, v_in, g_pre, u_pool = jnp.split(proj, split_at, axis=-1)
        o_rec = hgrn2(q_pre, f_pre, v_in, g_pre, lb_all[l], hgrn_norm_g[l])
        o_pool = pool_mixer(u_pool, pool_w[l], pool_scale[l])
        x = x + jnp.concatenate([o_rec, o_pool], axis=-1) @ w_out[l]
        h = rmsnorm(x, norm2_g[l])
        x = x + moe(h, router_w[l], router_b[l], w_gate[l], b_gate[l], w_up[l], b_up[l],
                    w_down[l], b_down[l])
    return rmsnorm(x, norm_f_g)
```

```cpp
#include <hip/hip_runtime.h>
#include <cstdio>
#include <cstdint>

#define LAS __attribute__((address_space(3)))
#define GAS __attribute__((address_space(1)))
typedef unsigned short bf16;
typedef short bf16x8 __attribute__((ext_vector_type(8)));
typedef float f32x4 __attribute__((ext_vector_type(4)));
typedef unsigned v4u __attribute__((ext_vector_type(4)));
typedef unsigned v2u __attribute__((ext_vector_type(2)));

#ifndef MK_PER_PHASE
#define MK_PER_PHASE 1
#endif

constexpr int NB = 4, SEQ = 8192, D = 1024, NTOK = NB * SEQ, INC = 2560, HW = 512, NH = 4, HD = 128;
constexpr int NE = 32, TOPK = 4, NROWS = NTOK * TOPK, FF = 1024;
constexpr float EPS = 1e-6f;
constexpr int NTHREADS = 512, NWAVES = 8;
constexpr int LDS_BYTES = 147456;

constexpr size_t KiB = 1024, MiB = 1024 * 1024;
constexpr size_t WS_CTL = 0, CTL_ZERO_BYTES = 64 * KiB;
constexpr size_t WS_POOLT = 512 * KiB;
constexpr size_t WS_WINT = 1 * MiB;
constexpr size_t WS_LIST = 1 * MiB;
constexpr size_t WS_TOKES = 5 * MiB;
constexpr size_t WS_TOKGATE = 5 * MiB + 512 * KiB;
constexpr size_t WS_WOUTT = 6 * MiB;
constexpr size_t WS_WD = 8 * MiB;
constexpr size_t WS_YSA = 72 * MiB;
constexpr size_t WS_WGU = 72 * MiB + 512 * KiB;
constexpr size_t WS_XN = 200 * MiB + 512 * KiB;
constexpr size_t WS_ACT = 264 * MiB + 512 * KiB;
constexpr size_t WS_PROJ = WS_ACT;
constexpr size_t WS_MIX = WS_PROJ + 160 * MiB;
constexpr size_t WS_END = WS_ACT + 256 * MiB + 1 * MiB;
constexpr int CW_CNT = 8192;
constexpr int CW_BAR = 0;

struct Params {
    const float *x, *norm1_g, *w_in, *hgrn_lb, *hgrn_norm_g, *pool_w, *pool_scale, *w_out, *norm2_g, *router_w, *router_b,
        *w_gate, *b_gate, *w_up, *b_up, *w_down, *b_down, *norm_f_g;
    float* out; unsigned char* ws; int ph_lo, ph_hi;
};

__device__ __forceinline__ unsigned f2bf(float f) { unsigned u = __float_as_uint(f); return (u + 0x7fffu + ((u >> 16) & 1u)) >> 16; }
__device__ __forceinline__ unsigned pk2(float lo, float hi) { return f2bf(lo) | (f2bf(hi) << 16); }
__device__ __forceinline__ float bf2f(unsigned b) { return __uint_as_float(b << 16); }
__device__ __forceinline__ float wave_sum(float v) {
#pragma unroll
    for (int o = 1; o < 64; o <<= 1) v += __shfl_xor(v, o);
    return v;
}
__device__ __forceinline__ float sigmoidf_(float z) { return 1.0f / (1.0f + __expf(-z)); }

#define XB_TMO      128
#define XB_XCNT(j)  (256  + 64 * (j))
#define XB_XSUB(j)  (1280 + 64 * (j))
#define XB_XGEN(j)  (2304 + 64 * (j))
#define XB_TOP      3328
#define XB_TOPGEN   3392
#define XCD_BAR_WORDS 3456
#define XB_SPIN_CAP (1u << 18)
__device__ __forceinline__ unsigned xb_ld(unsigned* p)              { return __hip_atomic_load(p, __ATOMIC_RELAXED, __HIP_MEMORY_SCOPE_AGENT); }
__device__ __forceinline__ unsigned xb_add(unsigned* p, unsigned v) { return __hip_atomic_fetch_add(p, v, __ATOMIC_RELAXED, __HIP_MEMORY_SCOPE_AGENT); }
__device__ __forceinline__ unsigned xb_xcc_id() { return (unsigned)__builtin_amdgcn_s_getreg((3 << 11) | 20) & 0xFu; }
#define XB_SPIN(cond, bar) do { unsigned _sp = 0; while (cond) { __builtin_amdgcn_s_sleep(1); \
    if ((++_sp & 255u) == 0u) { if (xb_ld(&(bar)[XB_TMO])) break; if (_sp > XB_SPIN_CAP) { atomicAdd(&(bar)[XB_TMO], 1u); break; } } } } while (0)
struct XcdBarrier { unsigned* bar; unsigned x; volatile LAS unsigned* st; };
__device__ __forceinline__ XcdBarrier xcd_barrier_post(unsigned* bar, volatile LAS unsigned* st) {
    XcdBarrier b; b.bar = bar; b.x = xb_xcc_id(); b.st = st;
    if (threadIdx.x == 0) (void)xb_add(&bar[XB_XCNT(b.x)], 1u);
    return b;
}
__device__ __forceinline__ void xcd_barrier_complete(unsigned* bar, unsigned x, unsigned& nloc, unsigned& nx) {
    const unsigned G = gridDim.x * gridDim.y * gridDim.z;
    unsigned sum, cnt, mine, sp = 0u;
    for (;;) {
        sum = 0u; cnt = 0u; mine = 0u;
#pragma unroll
        for (unsigned j = 0; j < 16; ++j) { const unsigned c = xb_ld(&bar[XB_XCNT(j)]); sum += c; cnt += (c > 0u) ? 1u : 0u; mine = (j == x) ? c : mine; }
        if (sum == G) break;
        __builtin_amdgcn_s_sleep(1);
        if ((++sp & 255u) == 0u) { if (xb_ld(&bar[XB_TMO])) break; if (sp > XB_SPIN_CAP) { atomicAdd(&bar[XB_TMO], 1u); break; } }
    }
    nloc = mine > 0u ? mine : 1u; nx = cnt > 0u ? cnt : 1u;
}
__device__ __forceinline__ void xcd_barrier(const XcdBarrier& b) {
    asm volatile("s_waitcnt vmcnt(0)" ::: "memory");
    __syncthreads();
    if (threadIdx.x == 0) {
        unsigned* bar = b.bar;
        __builtin_amdgcn_s_waitcnt(0);
        unsigned nloc = b.st[0], nx = b.st[1];
        if (nloc == 0u) { xcd_barrier_complete(bar, b.x, nloc, nx); b.st[0] = nloc; b.st[1] = nx; }
        const unsigned old = xb_add(&bar[XB_XSUB(b.x)], 1u);
        const unsigned gen = old / nloc;
        if (old + 1u == (gen + 1u) * nloc) {
            __builtin_amdgcn_fence(__ATOMIC_RELEASE, "agent");
            asm volatile("s_waitcnt vmcnt(0)" ::: "memory");
            const unsigned og = xb_add(&bar[XB_TOP], 1u);
            const unsigned tg = og / nx;
            if (og + 1u == (tg + 1u) * nx) xb_add(&bar[XB_TOPGEN], 1u);
            else XB_SPIN(xb_ld(&bar[XB_TOPGEN]) == tg, bar);
            __builtin_amdgcn_fence(__ATOMIC_ACQUIRE, "agent");
            xb_add(&bar[XB_XGEN(b.x)], 1u);
            asm volatile("s_waitcnt vmcnt(0)" ::: "memory");
        } else {
            XB_SPIN(xb_ld(&bar[XB_XGEN(b.x)]) == gen, bar);
            __builtin_amdgcn_fence(__ATOMIC_ACQUIRE, "agent");
            asm volatile("s_waitcnt vmcnt(0)" ::: "memory");
        }
    }
    __syncthreads();
}

struct Frame {
    LAS unsigned char* lds;
    int tid, lane, wave, G, bid, gw, NGW;
};

__device__ __forceinline__ void transpose_item(const float* W, int K, int N, bf16* WT, int ldt, int k0, int n0, int rowbase, LAS float* scr, int lane) {
#pragma unroll 8
    for (int i = 0; i < 32; ++i) { const int kk = 2 * i + (lane >> 5); scr[kk * 33 + (lane & 31)] = W[(size_t)(k0 + kk) * N + n0 + (lane & 31)]; }
    asm volatile("s_waitcnt lgkmcnt(0)" ::: "memory");
    const int c = lane & 7;
#pragma unroll
    for (int j = 0; j < 4; ++j) { const int n = (lane >> 3) + 8 * j; const LAS float* s = scr + (8 * c) * 33 + n;
        v4u o; o.x = pk2(s[0 * 33], s[1 * 33]); o.y = pk2(s[2 * 33], s[3 * 33]); o.z = pk2(s[4 * 33], s[5 * 33]); o.w = pk2(s[6 * 33], s[7 * 33]);
        *(v4u*)(WT + (size_t)(rowbase + n) * ldt + k0 + 8 * c) = o; }
    asm volatile("s_waitcnt lgkmcnt(0)" ::: "memory");
}

__device__ __forceinline__ void phase_prep(const Params& p, Frame& F) {
    LAS float* scr = (LAS float*)(F.lds + F.wave * 16384);
    bf16* WINT = (bf16*)(p.ws + WS_WINT); bf16* WOUTT = (bf16*)(p.ws + WS_WOUTT); bf16* WD = (bf16*)(p.ws + WS_WD); bf16* WGU = (bf16*)(p.ws + WS_WGU);
    bf16* POOLT = (bf16*)(p.ws + WS_POOLT); bf16* XN = (bf16*)(p.ws + WS_XN);
    constexpr int I_IN = (D / 64) * (INC / 32), I_OUT = (D / 64) * (D / 32), I_POOL = 4 * (128 / 64) * (128 / 32), I_E = (D / 64) * (FF / 32);
    constexpr int NITEMS = I_IN + I_OUT + I_POOL + 3 * NE * I_E;
    for (int it = F.gw; it < NITEMS; it += F.NGW) {
        int r = it;
        if (r < I_IN) { const int nb = INC / 32; transpose_item(p.w_in, D, INC, WINT, D, 64 * (r / nb), 32 * (r % nb), 32 * (r % nb), scr, F.lane); continue; } r -= I_IN;
        if (r < I_OUT) { const int nb = D / 32; transpose_item(p.w_out, D, D, WOUTT, D, 64 * (r / nb), 32 * (r % nb), 32 * (r % nb), scr, F.lane); continue; } r -= I_OUT;
        if (r < I_POOL) { const int g = r / 8, q = r % 8; transpose_item(p.pool_w + (size_t)g * 128 * 128, 128, 128, POOLT + (size_t)g * 128 * 128, 128, 64 * (q / 4), 32 * (q % 4), 32 * (q % 4), scr, F.lane); continue; } r -= I_POOL;
        const int mat = r / (NE * I_E); r -= mat * (NE * I_E);
        const int e = r / I_E, q = r % I_E; const int nb = FF / 32, k0 = 64 * (q / nb), n0 = 32 * (q % nb);
        if (mat == 0) transpose_item(p.w_gate + (size_t)e * D * FF, D, FF, WGU + (size_t)e * 2048 * D, D, k0, n0, (n0 / 128) * 256 + (n0 % 128), scr, F.lane);
        else if (mat == 1) transpose_item(p.w_up + (size_t)e * D * FF, D, FF, WGU + (size_t)e * 2048 * D, D, k0, n0, (n0 / 128) * 256 + 128 + (n0 % 128), scr, F.lane);
        else transpose_item(p.w_down + (size_t)e * FF * D, FF, D, WD + (size_t)e * D * FF, FF, k0, n0, n0, scr, F.lane);
    }
    for (int m = F.gw; m < NTOK; m += F.NGW) {
        const f32x4* xr = (const f32x4*)(p.x + (size_t)m * D) + F.lane; const f32x4* gr = (const f32x4*)p.norm1_g + F.lane;
        f32x4 v[4]; float s = 0.f;
#pragma unroll
        for (int j = 0; j < 4; ++j) { v[j] = xr[64 * j]; s += (v[j].x * v[j].x + v[j].y * v[j].y) + (v[j].z * v[j].z + v[j].w * v[j].w); }
        const float rstd = 1.0f / sqrtf(wave_sum(s) * (1.0f / D) + EPS);
        v2u* o8 = (v2u*)(XN + (size_t)m * D) + F.lane;
#pragma unroll
        for (int j = 0; j < 4; ++j) { const f32x4 g = gr[64 * j]; v2u w; w.x = pk2(v[j].x * rstd * g.x, v[j].y * rstd * g.y); w.y = pk2(v[j].z * rstd * g.z, v[j].w * rstd * g.w); o8[64 * j] = w; }
    }
}

__device__ __forceinline__ void wave_gemm_32x32(const bf16* a0, const bf16* a1, const bf16* b0, const bf16* b1, int K, int q, f32x4 (&acc)[2][2]) {
#pragma unroll 2
    for (int k0 = 0; k0 < K; k0 += 32) {
        const bf16x8 A0 = *(const bf16x8*)(a0 + k0 + 8 * q), A1 = *(const bf16x8*)(a1 + k0 + 8 * q);
        const bf16x8 B0 = *(const bf16x8*)(b0 + k0 + 8 * q), B1 = *(const bf16x8*)(b1 + k0 + 8 * q);
        acc[0][0] = __builtin_amdgcn_mfma_f32_16x16x32_bf16(A0, B0, acc[0][0], 0, 0, 0);
        acc[0][1] = __builtin_amdgcn_mfma_f32_16x16x32_bf16(A0, B1, acc[0][1], 0, 0, 0);
        acc[1][0] = __builtin_amdgcn_mfma_f32_16x16x32_bf16(A1, B0, acc[1][0], 0, 0, 0);
        acc[1][1] = __builtin_amdgcn_mfma_f32_16x16x32_bf16(A1, B1, acc[1][1], 0, 0, 0);
    }
}

__device__ __forceinline__ void phase_inproj_simple(const Params& p, Frame& F) {
    const bf16* XN = (const bf16*)(p.ws + WS_XN); const bf16* WINT = (const bf16*)(p.ws + WS_WINT); bf16* PROJ = (bf16*)(p.ws + WS_PROJ);
    const int fr = F.lane & 15, q = F.lane >> 4; constexpr int NT = INC / 32;
    for (int t = F.gw; t < (NTOK / 32) * NT; t += F.NGW) {
        const int tr = t / NT, tc = t % NT;
        f32x4 acc[2][2] = {};
        wave_gemm_32x32(XN + (size_t)(tr * 32 + fr) * D, XN + (size_t)(tr * 32 + 16 + fr) * D, WINT + (size_t)(tc * 32 + fr) * D, WINT + (size_t)(tc * 32 + 16 + fr) * D, D, q, acc);
#pragma unroll
        for (int i = 0; i < 2; ++i)
#pragma unroll
            for (int j = 0; j < 2; ++j)
#pragma unroll
                for (int r = 0; r < 4; ++r) PROJ[(size_t)(tr * 32 + i * 16 + 4 * q + r) * INC + tc * 32 + j * 16 + fr] = (bf16)f2bf(acc[i][j][r]);
    }
}

__device__ __forceinline__ void phase_outproj_simple(const Params& p, Frame& F) {
    const bf16* MIX = (const bf16*)(p.ws + WS_MIX); const bf16* WOUTT = (const bf16*)(p.ws + WS_WOUTT);
    const int fr = F.lane & 15, q = F.lane >> 4; constexpr int NT = D / 32;
    for (int t = F.gw; t < (NTOK / 32) * NT; t += F.NGW) {
        const int tr = t / NT, tc = t % NT;
        f32x4 acc[2][2] = {};
        wave_gemm_32x32(MIX + (size_t)(tr * 32 + fr) * D, MIX + (size_t)(tr * 32 + 16 + fr) * D, WOUTT + (size_t)(tc * 32 + fr) * D, WOUTT + (size_t)(tc * 32 + 16 + fr) * D, D, q, acc);
#pragma unroll
        for (int i = 0; i < 2; ++i)
#pragma unroll
            for (int j = 0; j < 2; ++j)
#pragma unroll
                for (int r = 0; r < 4; ++r) { const size_t o = (size_t)(tr * 32 + i * 16 + 4 * q + r) * D + tc * 32 + j * 16 + fr; p.out[o] = p.x[o] + acc[i][j][r]; }
    }
}

__device__ __forceinline__ void phase_mixer_simple(const Params& p, Frame& F) {
    const bf16* PROJ = (const bf16*)(p.ws + WS_PROJ); bf16* MIX = (bf16*)(p.ws + WS_MIX);
    LAS float* qs = (LAS float*)F.lds; LAS float* fs = qs + 128; LAS float* ks = fs + 128; LAS float* red = ks + 128;
    for (int u = F.bid; u < NB * NH; u += F.G) {
        const int b = u / NH, h = u % NH, c = F.tid, ch = h * HD + (c & 127);
        const float a0 = p.hgrn_lb[ch], a1 = p.hgrn_lb[HW + ch]; const float lb = 1.0f / (1.0f + __expf(a1 - a0));
        const float ng = p.hgrn_norm_g[c & 127];
        float S[128];
#pragma unroll
        for (int k = 0; k < 128; ++k) S[k] = 0.f;
        for (int t = 0; t < SEQ; ++t) {
            const bf16* row = PROJ + (size_t)(b * SEQ + t) * INC;
            float vt = 0.f, gt = 0.f;
            if (c < 128) {
                const float qp = bf2f(row[ch]), fp = bf2f(row[HW + ch]); vt = bf2f(row[2 * HW + ch]); gt = bf2f(row[3 * HW + ch]);
                const float f = lb + (1.0f - lb) * sigmoidf_(fp);
                qs[c] = qp * sigmoidf_(qp); fs[c] = f; ks[c] = 1.0f - f;
            }
            __syncthreads();
            float o = 0.f;
            if (c < 128) {
#pragma unroll
                for (int k = 0; k < 128; ++k) { S[k] = fs[k] * S[k] + ks[k] * vt; o += qs[k] * S[k]; }
            }
            float ss = wave_sum(o * o);
            if (c < 128 && F.lane == 0) red[F.wave] = ss;
            __syncthreads();
            if (c < 128) {
                const float tot = red[0] + red[1];
                const float r = o * (1.0f / sqrtf(tot * (1.0f / HD) + EPS)) * ng * (gt * sigmoidf_(gt));
                MIX[(size_t)(b * SEQ + t) * D + ch] = (bf16)f2bf(r);
            }
            __syncthreads();
        }
    }
    LAS float* dsm = (LAS float*)(F.lds + 4096) + F.wave * 128;
    for (int u = F.gw; u < NTOK * 4; u += F.NGW) {
        const int tok = u >> 2, g = u & 3, s = tok % SEQ, win = 2 << g;
        const int n = (s + 1 < win) ? (s + 1) : win;
#pragma unroll
        for (int hh = 0; hh < 2; ++hh) {
            const int c = F.lane + 64 * hh; const bf16* col = PROJ + (size_t)tok * INC + 4 * HW + g * 128 + c;
            float sum = 0.f; for (int j = 0; j < n; ++j) sum += bf2f(*(col - (size_t)j * INC));
            dsm[c] = sum / (float)n - bf2f(*col);
        }
        asm volatile("s_waitcnt lgkmcnt(0)" ::: "memory");
        const float* W = p.pool_w + (size_t)g * 128 * 128;
        float o0 = 0.f, o1 = 0.f;
        for (int c = 0; c < 128; ++c) { const float dv = dsm[c]; o0 += dv * W[c * 128 + F.lane]; o1 += dv * W[c * 128 + 64 + F.lane]; }
        bf16* orow = MIX + (size_t)tok * D + HW + g * 128;
        orow[F.lane] = (bf16)f2bf(o0 * p.pool_scale[g * 128 + F.lane]); orow[64 + F.lane] = (bf16)f2bf(o1 * p.pool_scale[g * 128 + 64 + F.lane]);
        asm volatile("s_waitcnt lgkmcnt(0)" ::: "memory");
    }
}

__device__ __forceinline__ void phase_route_simple(const Params& p, Frame& F) {
    bf16* XN = (bf16*)(p.ws + WS_XN); unsigned* ctl = (unsigned*)(p.ws + WS_CTL);
    int* LIST = (int*)(p.ws + WS_LIST); int* TOKES = (int*)(p.ws + WS_TOKES); float* TOKG = (float*)(p.ws + WS_TOKGATE);
    LAS float* hs = (LAS float*)F.lds + F.wave * 1024;
    for (int m = F.gw; m < NTOK; m += F.NGW) {
        const f32x4* xr = (const f32x4*)(p.out + (size_t)m * D) + F.lane; const f32x4* gr = (const f32x4*)p.norm2_g + F.lane;
        f32x4 v[4]; float s = 0.f;
#pragma unroll
        for (int j = 0; j < 4; ++j) { v[j] = xr[64 * j]; s += (v[j].x * v[j].x + v[j].y * v[j].y) + (v[j].z * v[j].z + v[j].w * v[j].w); }
        const float rstd = 1.0f / sqrtf(wave_sum(s) * (1.0f / D) + EPS);
        v2u* o8 = (v2u*)(XN + (size_t)m * D) + F.lane;
#pragma unroll
        for (int j = 0; j < 4; ++j) { const f32x4 g = gr[64 * j]; f32x4 hv; hv.x = v[j].x * rstd * g.x; hv.y = v[j].y * rstd * g.y; hv.z = v[j].z * rstd * g.z; hv.w = v[j].w * rstd * g.w;
            v2u w; w.x = pk2(hv.x, hv.y); w.y = pk2(hv.z, hv.w); o8[64 * j] = w; *((LAS f32x4*)hs + F.lane + 64 * j) = hv; }
        asm volatile("s_waitcnt lgkmcnt(0)" ::: "memory");
        const int e = F.lane & 31, half = F.lane >> 5;
        float acc = 0.f;
        for (int k = half * 512; k < half * 512 + 512; ++k) acc += hs[k] * p.router_w[k * NE + e];
        acc += __shfl_xor(acc, 32);
        float val = (F.lane < 32) ? acc + p.router_b[e] : -INFINITY;
        float tv[4]; int te[4];
#pragma unroll
        for (int r = 0; r < 4; ++r) {
            float bv = val; int bi = F.lane;
#pragma unroll
            for (int o = 1; o < 64; o <<= 1) { const float ov = __shfl_xor(bv, o); const int oi = __shfl_xor(bi, o); if (ov > bv || (ov == bv && oi < bi)) { bv = ov; bi = oi; } }
            tv[r] = bv; te[r] = bi; if (F.lane == bi) val = -INFINITY;
        }
        const float e1 = __expf(tv[1] - tv[0]), e2 = __expf(tv[2] - tv[0]), e3 = __expf(tv[3] - tv[0]); const float inv = 1.0f / (1.0f + e1 + e2 + e3);
        if (F.lane < 4) {
            const int ee = F.lane == 0 ? te[0] : F.lane == 1 ? te[1] : F.lane == 2 ? te[2] : te[3];
            const float gg = (F.lane == 0 ? 1.0f : F.lane == 1 ? e1 : F.lane == 2 ? e2 : e3) * inv;
            const unsigned slot = atomicAdd(ctl + CW_CNT + 64 * ee, 1u);
            LIST[ee * NTOK + slot] = m; TOKES[m * 4 + F.lane] = (ee << 16) | (int)slot; TOKG[m * 4 + F.lane] = gg;
        }
        asm volatile("s_waitcnt lgkmcnt(0)" ::: "memory");
    }
}

__device__ __forceinline__ void load_bases(const Params& p, Frame& F, LAS int* sb) {
    unsigned* ctl = (unsigned*)(p.ws + WS_CTL);
    __syncthreads();
    if (F.tid == 0) {
        int acc = 0, split = -1;
        for (int e = 0; e < NE; ++e) { const int c = (int)__hip_atomic_load(ctl + CW_CNT + 64 * e, __ATOMIC_RELAXED, __HIP_MEMORY_SCOPE_AGENT); sb[e] = acc;
            if (split < 0 && acc + c > 65536) { int sp = acc + ((65536 - acc + 255) / 256) * 256; if (sp < acc) sp = acc; if (sp > acc + c) sp = acc + c; split = sp; }
            acc += c; }
        sb[NE] = acc; sb[40] = split < 0 ? acc : split;
    }
    __syncthreads();
}

__device__ __forceinline__ void phase_gateup_simple(const Params& p, Frame& F) {
    const bf16* XN = (const bf16*)(p.ws + WS_XN); const bf16* WGU = (const bf16*)(p.ws + WS_WGU); bf16* ACT = (bf16*)(p.ws + WS_ACT); const int* LIST = (const int*)(p.ws + WS_LIST);
    LAS int* sb = (LAS int*)(F.lds + 65536); load_bases(p, F, sb);
    const int fr = F.lane & 15, q = F.lane >> 4;
    int tbase = 0;
    for (int e = 0; e < NE; ++e) {
        const int cnt = sb[e + 1] - sb[e], nrt = (cnt + 15) / 16, ntile = nrt * 64;
        int first = F.gw - (tbase % F.NGW); if (first < 0) first += F.NGW;
        for (int t = first; t < ntile; t += F.NGW) {
            const int rt = t / 64, ct = t % 64;
            int r = rt * 16 + fr; if (r >= cnt) r = 0;
            const bf16* arow = XN + (size_t)LIST[e * NTOK + r] * D;
            const bf16* brow_g = WGU + ((size_t)e * 2048 + (ct / 8) * 256 + (ct % 8) * 16 + fr) * D; const bf16* brow_u = brow_g + (size_t)128 * D;
            f32x4 ag = {0.f, 0.f, 0.f, 0.f}, au = {0.f, 0.f, 0.f, 0.f};
#pragma unroll 2
            for (int k0 = 0; k0 < D; k0 += 32) {
                const bf16x8 A = *(const bf16x8*)(arow + k0 + 8 * q), Bg = *(const bf16x8*)(brow_g + k0 + 8 * q), Bu = *(const bf16x8*)(brow_u + k0 + 8 * q);
                ag = __builtin_amdgcn_mfma_f32_16x16x32_bf16(A, Bg, ag, 0, 0, 0); au = __builtin_amdgcn_mfma_f32_16x16x32_bf16(A, Bu, au, 0, 0, 0);
            }
            const int col = ct * 16 + fr; const float bg = p.b_gate[e * FF + col], bu = p.b_up[e * FF + col];
#pragma unroll
            for (int j = 0; j < 4; ++j) { const int rr = rt * 16 + 4 * q + j; if (rr < cnt) {
                const float gt = fminf(ag[j] + bg, 7.0f); const float up = fminf(fmaxf(au[j] + bu, -7.0f), 7.0f);
                ACT[(size_t)(sb[e] + rr) * FF + col] = (bf16)f2bf((up + 1.0f) * (gt * sigmoidf_(1.702f * gt))); } }
        }
        tbase += ntile;
    }
}

__device__ __forceinline__ void phase_down_simple(const Params& p, Frame& F, int part) {
    const bf16* WD = (const bf16*)(p.ws + WS_WD); bf16* ACT = (bf16*)(p.ws + WS_ACT); bf16* YSA = (bf16*)(p.ws + WS_YSA);
    LAS int* sb = (LAS int*)(F.lds + 65536); load_bases(p, F, sb);
    const int fr = F.lane & 15, q = F.lane >> 4, split = sb[40];
    int tbase = 0;
    for (int e = 0; e < NE; ++e) {
        const int cnt = sb[e + 1] - sb[e], nrt = (cnt + 15) / 16, ntile = nrt * 64;
        int first = F.gw - (tbase % F.NGW); if (first < 0) first += F.NGW;
        for (int t = first; t < ntile; t += F.NGW) {
            const int rt = t / 64, ct = t % 64;
            const int row0 = sb[e] + rt * 16;
            if ((row0 >= split) != (part == 1)) continue;
            int r = rt * 16 + fr; if (r >= cnt) r = 0;
            const bf16* arow = ACT + (size_t)(sb[e] + r) * FF;
            const bf16* brow = WD + ((size_t)e * D + ct * 16 + fr) * FF;
            f32x4 acc = {0.f, 0.f, 0.f, 0.f};
#pragma unroll 2
            for (int k0 = 0; k0 < FF; k0 += 32) {
                const bf16x8 A = *(const bf16x8*)(arow + k0 + 8 * q), Bv = *(const bf16x8*)(brow + k0 + 8 * q);
                acc = __builtin_amdgcn_mfma_f32_16x16x32_bf16(A, Bv, acc, 0, 0, 0);
            }
            const int col = ct * 16 + fr; const float bd = p.b_down[e * D + col];
#pragma unroll
            for (int j = 0; j < 4; ++j) { const int rr = rt * 16 + 4 * q + j; if (rr < cnt) { const int grow = sb[e] + rr;
                bf16* dst = (grow < split) ? YSA + (size_t)grow * D : ACT + (size_t)(grow - split) * D; dst[col] = (bf16)f2bf(acc[j] + bd); } }
        }
        tbase += ntile;
    }
}

__device__ __forceinline__ void phase_final(const Params& p, Frame& F) {
    const bf16* ACT = (const bf16*)(p.ws + WS_ACT); const bf16* YSA = (const bf16*)(p.ws + WS_YSA);
    const int* TOKES = (const int*)(p.ws + WS_TOKES); const float* TOKG = (const float*)(p.ws + WS_TOKGATE);
    LAS int* sb = (LAS int*)(F.lds + 65536); load_bases(p, F, sb);
    const int split = sb[40];
    for (int m = F.gw; m < NTOK; m += F.NGW) {
        f32x4* xr = (f32x4*)(p.out + (size_t)m * D) + F.lane; const f32x4* gr = (const f32x4*)p.norm_f_g + F.lane;
        f32x4 v[4];
#pragma unroll
        for (int j = 0; j < 4; ++j) v[j] = xr[64 * j];
#pragma unroll
        for (int r = 0; r < 4; ++r) {
            const int es = TOKES[m * 4 + r]; const float g = TOKG[m * 4 + r]; const int row = sb[es >> 16] + (es & 0xffff);
            const bf16* src = (row < split) ? YSA + (size_t)row * D : ACT + (size_t)(row - split) * D;
            const v2u* s8 = (const v2u*)src + F.lane;
#pragma unroll
            for (int j = 0; j < 4; ++j) { const v2u w = s8[64 * j];
                v[j].x += g * bf2f(w.x & 0xffffu); v[j].y += g * bf2f(w.x >> 16); v[j].z += g * bf2f(w.y & 0xffffu); v[j].w += g * bf2f(w.y >> 16); }
        }
        float s = 0.f;
#pragma unroll
        for (int j = 0; j < 4; ++j) s += (v[j].x * v[j].x + v[j].y * v[j].y) + (v[j].z * v[j].z + v[j].w * v[j].w);
        const float rstd = 1.0f / sqrtf(wave_sum(s) * (1.0f / D) + EPS);
#pragma unroll
        for (int j = 0; j < 4; ++j) { const f32x4 g = gr[64 * j]; f32x4 o; o.x = v[j].x * rstd * g.x; o.y = v[j].y * rstd * g.y; o.z = v[j].z * rstd * g.z; o.w = v[j].w * rstd * g.w; xr[64 * j] = o; }
    }
}

constexpr int N_PHASES = 9;
__global__ void __launch_bounds__(NTHREADS, 2) fwd(Params p) {
    extern __shared__ __attribute__((aligned(16))) unsigned char lds[];
    Frame F; F.lds = (LAS unsigned char*)lds; F.tid = threadIdx.x; F.lane = F.tid & 63; F.wave = __builtin_amdgcn_readfirstlane(F.tid >> 6);
    F.G = gridDim.x; F.bid = blockIdx.x; F.gw = F.bid * NWAVES + F.wave; F.NGW = F.G * NWAVES;
    volatile LAS unsigned* MISC = (volatile LAS unsigned*)(F.lds + LDS_BYTES - 64);
    if (F.tid < 16) MISC[F.tid] = 0u;
    __syncthreads();
    const int lo = p.ph_lo, hi = p.ph_hi;
    XcdBarrier bar; bar.bar = (unsigned*)(p.ws + WS_CTL) + CW_BAR; bar.x = 0; bar.st = nullptr;
    if (hi - lo > 1) bar = xcd_barrier_post((unsigned*)(p.ws + WS_CTL) + CW_BAR, MISC + 8);
#define IN(k) (lo <= (k) && (k) < hi)
#define SEAM(k) do { if (IN(k) && IN((k) + 1)) xcd_barrier(bar); } while (0)
    if (IN(0)) { phase_prep(p, F); } SEAM(0);
    if (IN(1)) { phase_inproj_simple(p, F); } SEAM(1);
    if (IN(2)) { phase_mixer_simple(p, F); } SEAM(2);
    if (IN(3)) { phase_outproj_simple(p, F); } SEAM(3);
    if (IN(4)) { phase_route_simple(p, F); } SEAM(4);
    if (IN(5)) { phase_gateup_simple(p, F); } SEAM(5);
    if (IN(6)) { phase_down_simple(p, F, 0); } SEAM(6);
    if (IN(7)) { phase_down_simple(p, F, 1); } SEAM(7);
    if (IN(8)) { phase_final(p, F); }
#undef IN
#undef SEAM
}

extern "C" void kernel_launch(void* const* d_in, const int* in_sizes, int n_in, void* d_out, int out_size, void* d_ws, size_t ws_size, hipStream_t stream) {
    static int grid = 0;
    if (grid == 0) {
        if (n_in != 18 || in_sizes[0] != NTOK * D || out_size != NTOK * D || ws_size < WS_END) {
            fprintf(stderr, "kernel_launch: unexpected shapes / workspace (n_in %d, in0 %d, out %d, ws %zu, need %zu); nothing launched\n", n_in, n_in > 0 ? in_sizes[0] : -1, out_size, ws_size, (size_t)WS_END);
            grid = -1; return; }
        int dev = 0, cus = 0;
        if (hipGetDevice(&dev) != hipSuccess || hipDeviceGetAttribute(&cus, hipDeviceAttributeMultiprocessorCount, dev) != hipSuccess) { grid = -1; return; }
        if (hipFuncSetAttribute((const void*)fwd, hipFuncAttributeMaxDynamicSharedMemorySize, LDS_BYTES) != hipSuccess) { fprintf(stderr, "kernel_launch: hipFuncSetAttribute failed\n"); grid = -1; return; }
        int per_cu = 0;
        if (hipOccupancyMaxActiveBlocksPerMultiprocessor(&per_cu, (const void*)fwd, NTHREADS, LDS_BYTES) != hipSuccess || per_cu < 1) fprintf(stderr, "kernel_launch: occupancy query says %d\n", per_cu);
        (void)hipGetLastError();
        grid = cus;
    }
    if (grid < 0) return;
    (void)hipMemsetAsync((char*)d_ws + WS_CTL, 0, CTL_ZERO_BYTES, stream);
    Params p{};
    p.x = (const float*)d_in[0]; p.norm1_g = (const float*)d_in[1]; p.w_in = (const float*)d_in[2]; p.hgrn_lb = (const float*)d_in[3]; p.hgrn_norm_g = (const float*)d_in[4];
    p.pool_w = (const float*)d_in[5]; p.pool_scale = (const float*)d_in[6]; p.w_out = (const float*)d_in[7]; p.norm2_g = (const float*)d_in[8]; p.router_w = (const float*)d_in[9];
    p.router_b = (const float*)d_in[10]; p.w_gate = (const float*)d_in[11]; p.b_gate = (const float*)d_in[12]; p.w_up = (const float*)d_in[13]; p.b_up = (const float*)d_in[14];
    p.w_down = (const float*)d_in[15]; p.b_down = (const float*)d_in[16]; p.norm_f_g = (const float*)d_in[17];
    p.out = (float*)d_out; p.ws = (unsigned char*)d_ws;
#if MK_PER_PHASE
    for (int k = 0; k < N_PHASES; ++k) { p.ph_lo = k; p.ph_hi = k + 1; hipLaunchKernelGGL(fwd, dim3(grid), dim3(NTHREADS), LDS_BYTES, stream, p); }
#else
    p.ph_lo = 0; p.ph_hi = N_PHASES; hipLaunchKernelGGL(fwd, dim3(grid), dim3(NTHREADS), LDS_BYTES, stream, p);
#endif
}
```

```cpp
#include <hip/hip_runtime.h>
#include <cstdio>
#include <cstdint>

#define LAS __attribute__((address_space(3)))
#define GAS __attribute__((address_space(1)))
typedef unsigned short bf16;
typedef short bf16x8 __attribute__((ext_vector_type(8)));
typedef float f32x4 __attribute__((ext_vector_type(4)));
typedef unsigned v4u __attribute__((ext_vector_type(4)));
typedef unsigned v2u __attribute__((ext_vector_type(2)));

#ifndef MK_PER_PHASE
#define MK_PER_PHASE 0
#endif

constexpr int NB = 4, SEQ = 8192, D = 1024, NTOK = NB * SEQ, INC = 2560, HW = 512, NH = 4, HD = 128;
constexpr int NE = 32, TOPK = 4, NROWS = NTOK * TOPK, FF = 1024;
constexpr float EPS = 1e-6f;
constexpr int NTHREADS = 512, NWAVES = 8;
constexpr int LDS_BYTES = 163840;
constexpr int LDS_TAB = 131072, LDS_OB = 134144, OB_PITCH = 144, LDS_BIAS = 153600, LDS_RS = 161792;

constexpr size_t KiB = 1024, MiB = 1024 * 1024;
constexpr size_t WS_CTL = 0, CTL_ZERO_BYTES = 64 * KiB;
constexpr size_t WS_POOLT = 512 * KiB;
constexpr size_t WS_WRH = 768 * KiB, WS_WRL = 832 * KiB;
constexpr size_t WS_WINT = 1 * MiB;
constexpr size_t WS_LIST = 1 * MiB;
constexpr size_t WS_TOKES = 5 * MiB;
constexpr size_t WS_TOKGATE = 5 * MiB + 512 * KiB;
constexpr size_t WS_WOUTT = 6 * MiB;
constexpr size_t WS_WD8 = 8 * MiB;
constexpr size_t WS_WGU8 = 40 * MiB;
constexpr size_t WS_H8 = 104 * MiB;
constexpr size_t WS_ACT8 = 136 * MiB;
constexpr size_t WS_XN = WS_ACT8;
constexpr size_t WS_YS = 264 * MiB + 512 * KiB;
constexpr size_t WS_RS = WS_YS;
constexpr size_t WS_PROJ = WS_YS;
constexpr size_t WS_MIX = WS_XN + 64 * MiB;
constexpr size_t WS_RSTD1 = 640 * KiB;
constexpr size_t WS_X1B = WS_YS + 160 * MiB;
constexpr size_t WS_HST = WS_YS + 224 * MiB;
constexpr size_t WS_HDEC = WS_HST + 16 * MiB;
constexpr size_t WS_END = WS_YS + 256 * MiB + 512 * KiB;
constexpr float WSCALE = 64.0f, WINV = 1.0f / 64.0f;
constexpr int CW_CNT = 8192;
constexpr int CW_BAR = 0;

struct Params {
    const float *x, *norm1_g, *w_in, *hgrn_lb, *hgrn_norm_g, *pool_w, *pool_scale, *w_out, *norm2_g, *router_w, *router_b,
        *w_gate, *b_gate, *w_up, *b_up, *w_down, *b_down, *norm_f_g;
    float* out; unsigned char* ws; int ph_lo, ph_hi;
};

__device__ __forceinline__ unsigned f2bf(float f) { unsigned u = __float_as_uint(f); return (u + 0x7fffu + ((u >> 16) & 1u)) >> 16; }
__device__ __forceinline__ unsigned pk2(float lo, float hi) { unsigned r; asm("v_cvt_pk_bf16_f32 %0, %1, %2" : "=v"(r) : "v"(lo), "v"(hi)); return r; }
__device__ __forceinline__ float bf2f(unsigned b) { return __uint_as_float(b << 16); }
__device__ __forceinline__ float wave_sum(float v) {
#pragma unroll
    for (int o = 1; o < 64; o <<= 1) v += __shfl_xor(v, o);
    return v;
}
#define LDS_SYNC() do { asm volatile("s_waitcnt lgkmcnt(0)" ::: "memory"); __builtin_amdgcn_s_barrier(); asm volatile("" ::: "memory"); } while (0)
__device__ __forceinline__ float rcpf_(float x) { return __builtin_amdgcn_rcpf(x); }
__device__ __forceinline__ float rsqf_(float x) { return __builtin_amdgcn_rsqf(x); }
__device__ __forceinline__ float ex2f_(float x) { return __builtin_amdgcn_exp2f(x); }
__device__ __forceinline__ float lg2f_(float x) { return __builtin_amdgcn_logf(x); }
__device__ __forceinline__ float sigmoidf_(float z) { return rcpf_(1.0f + ex2f_(-1.4426950408889634f * z)); }
__device__ __forceinline__ unsigned pk4_fp8(float a, float b, float c, float d) { int w = __builtin_amdgcn_cvt_pk_fp8_f32(a, b, 0, false); w = __builtin_amdgcn_cvt_pk_fp8_f32(c, d, w, true); return (unsigned)w; }

#define XB_TMO      128
#define XB_XCNT(j)  (256  + 64 * (j))
#define XB_XSUB(j)  (1280 + 64 * (j))
#define XB_XGEN(j)  (2304 + 64 * (j))
#define XB_TOP      3328
#define XB_TOPGEN   3392
#define XCD_BAR_WORDS 3456
#define XB_SPIN_CAP (1u << 18)
__device__ __forceinline__ unsigned xb_ld(unsigned* p)              { return __hip_atomic_load(p, __ATOMIC_RELAXED, __HIP_MEMORY_SCOPE_AGENT); }
__device__ __forceinline__ unsigned xb_add(unsigned* p, unsigned v) { return __hip_atomic_fetch_add(p, v, __ATOMIC_RELAXED, __HIP_MEMORY_SCOPE_AGENT); }
__device__ __forceinline__ unsigned xb_xcc_id() { return (unsigned)__builtin_amdgcn_s_getreg((3 << 11) | 20) & 0xFu; }
#define XB_SPIN(cond, bar) do { unsigned _sp = 0; while (cond) { __builtin_amdgcn_s_sleep(1); \
    if ((++_sp & 255u) == 0u) { if (xb_ld(&(bar)[XB_TMO])) break; if (_sp > XB_SPIN_CAP) { atomicAdd(&(bar)[XB_TMO], 1u); break; } } } } while (0)
struct XcdBarrier { unsigned* bar; unsigned x; volatile LAS unsigned* st; };
__device__ __forceinline__ XcdBarrier xcd_barrier_post(unsigned* bar, volatile LAS unsigned* st) {
    XcdBarrier b; b.bar = bar; b.x = xb_xcc_id(); b.st = st;
    if (threadIdx.x == 0) (void)xb_add(&bar[XB_XCNT(b.x)], 1u);
    return b;
}
__device__ __forceinline__ void xcd_barrier_complete(unsigned* bar, unsigned x, unsigned& nloc, unsigned& nx) {
    const unsigned G = gridDim.x * gridDim.y * gridDim.z;
    unsigned sum, cnt, mine, sp = 0u;
    for (;;) {
        sum = 0u; cnt = 0u; mine = 0u;
#pragma unroll
        for (unsigned j = 0; j < 16; ++j) { const unsigned c = xb_ld(&bar[XB_XCNT(j)]); sum += c; cnt += (c > 0u) ? 1u : 0u; mine = (j == x) ? c : mine; }
        if (sum == G) break;
        __builtin_amdgcn_s_sleep(1);
        if ((++sp & 255u) == 0u) { if (xb_ld(&bar[XB_TMO])) break; if (sp > XB_SPIN_CAP) { atomicAdd(&bar[XB_TMO], 1u); break; } }
    }
    nloc = mine > 0u ? mine : 1u; nx = cnt > 0u ? cnt : 1u;
}
__device__ __forceinline__ void xcd_barrier(const XcdBarrier& b) {
    asm volatile("s_waitcnt vmcnt(0)" ::: "memory");
    __syncthreads();
    if (threadIdx.x == 0) {
        unsigned* bar = b.bar;
        __builtin_amdgcn_s_waitcnt(0);
        unsigned nloc = b.st[0], nx = b.st[1];
        if (nloc == 0u) { xcd_barrier_complete(bar, b.x, nloc, nx); b.st[0] = nloc; b.st[1] = nx; }
        const unsigned old = xb_add(&bar[XB_XSUB(b.x)], 1u);
        const unsigned gen = old / nloc;
        if (old + 1u == (gen + 1u) * nloc) {
            __builtin_amdgcn_fence(__ATOMIC_RELEASE, "agent");
            asm volatile("s_waitcnt vmcnt(0)" ::: "memory");
            const unsigned og = xb_add(&bar[XB_TOP], 1u);
            const unsigned tg = og / nx;
            if (og + 1u == (tg + 1u) * nx) xb_add(&bar[XB_TOPGEN], 1u);
            else XB_SPIN(xb_ld(&bar[XB_TOPGEN]) == tg, bar);
            __builtin_amdgcn_fence(__ATOMIC_ACQUIRE, "agent");
            xb_add(&bar[XB_XGEN(b.x)], 1u);
            asm volatile("s_waitcnt vmcnt(0)" ::: "memory");
        } else {
            XB_SPIN(xb_ld(&bar[XB_XGEN(b.x)]) == gen, bar);
            __builtin_amdgcn_fence(__ATOMIC_ACQUIRE, "agent");
            asm volatile("s_waitcnt vmcnt(0)" ::: "memory");
        }
    }
    __syncthreads();
}

struct Frame {
    LAS unsigned char* lds;
    int tid, lane, wave, G, bid, gw, NGW;
};

__device__ __forceinline__ void transpose_item(const float* W, int K, int N, bf16* WT, int ldt, int k0, int n0, int rowbase, LAS float* scr, int lane, const float* kscale = nullptr) {
#pragma unroll 32
    for (int i = 0; i < 32; ++i) { const int kk = 2 * i + (lane >> 5); scr[kk * 33 + (lane & 31)] = W[(size_t)(k0 + kk) * N + n0 + (lane & 31)] * (kscale ? kscale[k0 + kk] : 1.0f); }
    asm volatile("s_waitcnt lgkmcnt(0)" ::: "memory");
    const int c = lane & 7;
#pragma unroll
    for (int j = 0; j < 4; ++j) { const int n = (lane >> 3) + 8 * j; const LAS float* s = scr + (8 * c) * 33 + n;
        v4u o; o.x = pk2(s[0 * 33], s[1 * 33]); o.y = pk2(s[2 * 33], s[3 * 33]); o.z = pk2(s[4 * 33], s[5 * 33]); o.w = pk2(s[6 * 33], s[7 * 33]);
        *(v4u*)(WT + (size_t)(rowbase + n) * ldt + k0 + 8 * c) = o; }
    asm volatile("s_waitcnt lgkmcnt(0)" ::: "memory");
}

constexpr int CV_WGU = 2 * NE * 256, CV_WD = NE * 256, CV_WD_A = CV_WD / 2, CV_PITCH = 144, CV_LDS = 32 * CV_PITCH;
struct CvItem { const float* src; unsigned char* dst; };
__device__ __forceinline__ unsigned perm_b32(unsigned hi, unsigned lo, unsigned sel) { return __builtin_amdgcn_perm(hi, lo, sel); }
__device__ __forceinline__ CvItem cv_addr(const Params& p, int mat, int r, int lane) {
    const int e = r >> 8, kg = (r >> 5) & 7, ng = r & 31, k0 = 128 * kg, n0 = 32 * ng;
    const float* W = (mat == 0 ? p.w_gate : mat == 1 ? p.w_up : p.w_down) + (size_t)e * D * FF;
    CvItem c; c.src = W + (size_t)(k0 + 4 * (lane >> 3)) * FF + n0 + 4 * (lane & 7);
    if (mat == 2) c.dst = p.ws + WS_WD8 + ((size_t)e * D + n0) * FF + k0;
    else c.dst = p.ws + WS_WGU8 + ((size_t)e * 2048 + (n0 >> 7) * 256 + (mat == 1 ? 128 : 0) + (n0 & 127)) * D + k0;
    return c;
}
__device__ __forceinline__ void cv_load(const CvItem& c, f32x4 (&v)[16]) {
#pragma unroll
    for (int jj = 0; jj < 16; ++jj) v[jj] = *(const f32x4*)(c.src + (size_t)(32 * (jj >> 2) + (jj & 3)) * FF);
}
__device__ __forceinline__ void cv_store(const CvItem& c, const f32x4 (&v)[16], LAS unsigned char* scr, int lane) {
    const int g = lane >> 3, cq = lane & 7;
#pragma unroll
    for (int a = 0; a < 4; ++a) { unsigned d[4];
#pragma unroll
        for (int b = 0; b < 4; ++b) { const f32x4 x = v[4 * a + b] * WSCALE; d[b] = pk4_fp8(x[0], x[1], x[2], x[3]); }
        const unsigned x0 = perm_b32(d[1], d[0], 0x05010400u), x1 = perm_b32(d[1], d[0], 0x07030602u), y0 = perm_b32(d[3], d[2], 0x05010400u), y1 = perm_b32(d[3], d[2], 0x07030602u);
        LAS unsigned char* q = scr + (4 * cq) * CV_PITCH + 32 * a + 4 * g;
        *(LAS unsigned*)(q) = perm_b32(y0, x0, 0x05040100u); *(LAS unsigned*)(q + CV_PITCH) = perm_b32(y0, x0, 0x07060302u);
        *(LAS unsigned*)(q + 2 * CV_PITCH) = perm_b32(y1, x1, 0x05040100u); *(LAS unsigned*)(q + 3 * CV_PITCH) = perm_b32(y1, x1, 0x07060302u); }
    asm volatile("s_waitcnt lgkmcnt(0)" ::: "memory");
#pragma unroll
    for (int i = 0; i < 4; ++i) { const int row = (lane >> 3) + 8 * i, ch = lane & 7; const v4u w = *(const LAS v4u*)(scr + row * CV_PITCH + 16 * ch); *(v4u*)(c.dst + (size_t)row * D + 16 * ch) = w; }
    asm volatile("s_waitcnt lgkmcnt(0)" ::: "memory");
}
struct CvJob {
    int mat0, item, stride, limit; bool live; CvItem c; f32x4 v[16];
    __device__ __forceinline__ void init(int mat0_, int first, int stride_, int limit_) { mat0 = mat0_; item = first; stride = stride_; limit = limit_; live = false; }
    __device__ __forceinline__ void top(const Params& p, int lane) { live = item < limit; const int it = live ? item : 0;
        c = cv_addr(p, mat0 + it / (NE * 256), it % (NE * 256), lane); cv_load(c, v); }
    __device__ __forceinline__ void bottom(LAS unsigned char* scr, int lane) {
        if (live) {
#pragma unroll
            for (int jj = 0; jj < 16; ++jj) asm volatile("" : "+v"(v[jj]));
            cv_store(c, v, scr, lane); item += stride; live = false; }
    }
    __device__ __forceinline__ void rest(const Params& p, LAS unsigned char* scr, int lane) { run(p, scr, lane, 0x7fffffff / 2); }
    __device__ __forceinline__ void run(const Params& p, LAS unsigned char* scr, int lane, int n) {
        if (n > (limit - item + stride - 1) / stride) n = (limit - item + stride - 1) / stride;
        if (n <= 0) return;
        f32x4 vb[16]; CvItem c0 = addr_of(p, item, lane), c1;
        cv_load(c0, v);
        for (int k = 0; k < n; k += 2) {
            c1 = addr_of(p, item + ((k + 1 < n) ? stride : 0), lane); cv_load(c1, vb);
#pragma unroll
            for (int jj = 0; jj < 16; ++jj) asm volatile("" : "+v"(v[jj]));
            cv_store(c0, v, scr, lane); item += stride;
            if (k + 1 >= n) break;
            c0 = addr_of(p, item + ((k + 2 < n) ? stride : 0), lane); cv_load(c0, v);
#pragma unroll
            for (int jj = 0; jj < 16; ++jj) asm volatile("" : "+v"(vb[jj]));
            cv_store(c1, vb, scr, lane); item += stride;
        }
    }
    __device__ __forceinline__ CvItem addr_of(const Params& p, int it, int lane) const { return cv_addr(p, mat0 + it / (NE * 256), it % (NE * 256), lane); }
};

__device__ __forceinline__ void phase_prep(const Params& p, Frame& F) {
    LAS float* scr = (LAS float*)(F.lds + F.wave * 16896);
    bf16* WINT = (bf16*)(p.ws + WS_WINT); bf16* WOUTT = (bf16*)(p.ws + WS_WOUTT);
    bf16* POOLT = (bf16*)(p.ws + WS_POOLT); bf16* XN = (bf16*)(p.ws + WS_XN);
    constexpr int I_IN = (D / 64) * (INC / 32), I_OUT = (D / 64) * (D / 32), I_POOL = 4 * (128 / 64) * (128 / 32);
    constexpr int NITEMS = I_IN + I_OUT + I_POOL;
    for (int it = F.gw; it < NITEMS; it += F.NGW) {
        int r = it;
        if (r < I_IN) { const int nb = INC / 32; transpose_item(p.w_in, D, INC, WINT, D, 64 * (r / nb), 32 * (r % nb), 32 * (r % nb), scr, F.lane, p.norm1_g); continue; } r -= I_IN;
        if (r < I_OUT) { const int nb = D / 32; transpose_item(p.w_out, D, D, WOUTT, D, 64 * (r / nb), 32 * (r % nb), 32 * (r % nb), scr, F.lane); continue; } r -= I_OUT;
        { const int g = r / 8, q = r % 8; transpose_item(p.pool_w + (size_t)g * 128 * 128, 128, 128, POOLT + (size_t)g * 128 * 128, 128, 64 * (q / 4), 32 * (q % 4), 32 * (q % 4), scr, F.lane); }
    }
    { bf16* WRH = (bf16*)(p.ws + WS_WRH); bf16* WRL = (bf16*)(p.ws + WS_WRL);
      for (int i = F.bid * NTHREADS + F.tid; i < NE * D; i += F.G * NTHREADS) { const int e = i / D, k = i % D; const float wv = p.norm2_g[k] * p.router_w[k * NE + e]; const unsigned h = f2bf(wv); WRH[i] = (bf16)h; WRL[i] = (bf16)f2bf(wv - bf2f(h)); } }
    float* RSTD1 = (float*)(p.ws + WS_RSTD1);
    for (int m = 2 * F.gw; m < NTOK; m += 2 * F.NGW) {
        f32x4 v[2][4];
#pragma unroll
        for (int r = 0; r < 2; ++r)
#pragma unroll
            for (int j = 0; j < 4; ++j) v[r][j] = ((const f32x4*)(p.x + (size_t)(m + r) * D) + F.lane)[64 * j];
#pragma unroll
        for (int r = 0; r < 2; ++r) { float s = 0.f;
#pragma unroll
            for (int j = 0; j < 4; ++j) s += (v[r][j].x * v[r][j].x + v[r][j].y * v[r][j].y) + (v[r][j].z * v[r][j].z + v[r][j].w * v[r][j].w);
            const float rstd = rsqf_(wave_sum(s) * (1.0f / D) + EPS);
            if (F.lane == 0) RSTD1[m + r] = rstd;
            v2u* o8 = (v2u*)(XN + (size_t)(m + r) * D) + F.lane;
#pragma unroll
            for (int j = 0; j < 4; ++j) { v2u w; w.x = pk2(v[r][j].x, v[r][j].y); w.y = pk2(v[r][j].z, v[r][j].w); o8[64 * j] = w; } }
    }
}

__device__ __forceinline__ void load_tables(const Params& p, Frame& F, LAS int* sb);
typedef float hg2 __attribute__((ext_vector_type(2)));
__device__ __forceinline__ void phase_final(const Params& p, Frame& F) {
    const unsigned char* YS = p.ws + WS_YS; const bf16* X1B = (const bf16*)(p.ws + WS_X1B);
    const int* TOKES = (const int*)(p.ws + WS_TOKES); const float* TOKG = (const float*)(p.ws + WS_TOKGATE);
    LAS int* sb = (LAS int*)(F.lds + LDS_TAB); if (p.ph_lo > 6) load_tables(p, F, sb);
    const f32x4* gr = (const f32x4*)p.norm_f_g + F.lane;
    for (int m0 = 4 * F.gw; m0 < NTOK; m0 += 4 * F.NGW) {
        f32x4 v[4][4]; int es[4][4]; float gt[4][4];
#pragma unroll
        for (int r = 0; r < 4; ++r) {
#pragma unroll
            for (int k = 0; k < 4; ++k) { es[r][k] = TOKES[(m0 + r) * 4 + k]; gt[r][k] = TOKG[(m0 + r) * 4 + k]; }
#pragma unroll
            for (int j = 0; j < 4; ++j) { const v2u xw = ((const v2u*)(X1B + (size_t)(m0 + r) * D) + F.lane)[64 * j];
                v[r][j] = (f32x4){__uint_as_float(xw.x << 16), __uint_as_float(xw.x & 0xffff0000u), __uint_as_float(xw.y << 16), __uint_as_float(xw.y & 0xffff0000u)}; } }
#pragma unroll
        for (int r = 0; r < 4; ++r)
#pragma unroll
            for (int k = 0; k < 4; ++k) { const int row = sb[es[r][k] >> 16] + (es[r][k] & 0xffff); const float g = gt[r][k];
                const unsigned* s4 = (const unsigned*)(YS + (size_t)row * D) + F.lane;
                unsigned w[4];
#pragma unroll
                for (int j = 0; j < 4; ++j) w[j] = s4[64 * j];
#pragma unroll
                for (int j = 0; j < 4; ++j) { const hg2 lo = __builtin_amdgcn_cvt_pk_f32_fp8((int)w[j], false), hi = __builtin_amdgcn_cvt_pk_f32_fp8((int)w[j], true);
                    v[r][j].x += g * lo.x; v[r][j].y += g * lo.y; v[r][j].z += g * hi.x; v[r][j].w += g * hi.y; } }
#pragma unroll
        for (int r = 0; r < 4; ++r) { float s = 0.f;
#pragma unroll
            for (int j = 0; j < 4; ++j) s += (v[r][j].x * v[r][j].x + v[r][j].y * v[r][j].y) + (v[r][j].z * v[r][j].z + v[r][j].w * v[r][j].w);
            const float rstd = rsqf_(wave_sum(s) * (1.0f / D) + EPS);
            f32x4* xr = (f32x4*)(p.out + (size_t)(m0 + r) * D) + F.lane;
#pragma unroll
            for (int j = 0; j < 4; ++j) { const f32x4 g = gr[64 * j]; f32x4 o; o.x = v[r][j].x * rstd * g.x; o.y = v[r][j].y * rstd * g.y; o.z = v[r][j].z * rstd * g.z; o.w = v[r][j].w * rstd * g.w; xr[64 * j] = o; } }
    }
}

namespace gg {
constexpr int BM = 256, BK = 64, HALF = 128, HTB = HALF * BK * 2, STAGE_BYTES = 8 * HTB, NXCD = 8, WGM = 8;
typedef int i32x4 __attribute__((ext_vector_type(4)));
typedef int i32x8 __attribute__((ext_vector_type(8)));
__device__ __forceinline__ int lds_byte(int r, int c) { const int st = (r >> 4) * 2 + (c >> 5), rr = r & 15, cc = c & 31, ob = rr * 64 + cc * 2; return st * 1024 + (ob ^ (((ob >> 9) & 1) << 5)); }
__device__ __forceinline__ void stage_rc(int b, int& R, int& C) { const int st = b / 1024, sb = b % 1024, swz = sb ^ (((sb >> 9) & 1) << 5); R = (st >> 1) * 16 + swz / 64; C = (st & 1) * 32 + (swz % 64) / 2; }
__device__ __forceinline__ int perm32(int rho) { const int n = rho >> 4, i = rho & 15; return 8 * (i >> 2) + 4 * n + (i & 3); }
__device__ __forceinline__ unsigned cvt_pk_bf16(float lo, float hi) { unsigned r; asm volatile("v_cvt_pk_bf16_f32 %0, %1, %2" : "=v"(r) : "v"(lo), "v"(hi)); return r; }

struct Unit { const char* B; unsigned char* dst; int row0, nvalid, pn, e, r0, cnt; };

template <class Sched, class Epi>
__device__ __forceinline__ void gemm_phase(LAS unsigned char* lds, const Sched& S, const Epi& E) {
    const int tid = threadIdx.x, wid = __builtin_amdgcn_readfirstlane(tid >> 6), lane = tid & 63, wr = wid >> 2, wc = wid & 3, fr = lane & 15, fq = lane >> 4;
    constexpr int KB = Sched::KB, nt = KB / 128; constexpr bool F8 = Sched::F8;
    int R[2], C[2]; unsigned voffB[2];
#pragma unroll
    for (int i = 0; i < 2; ++i) { stage_rc(tid * 16 + i * 8192, R[i], C[i]); const int Rb = Epi::PERM ? ((R[i] & ~31) + perm32(R[i] & 31)) : R[i]; voffB[i] = (unsigned)(Rb * KB + C[i] * 2); }
    const size_t kstep = (size_t)(BK * 2);
    const size_t hstep = (size_t)HALF * KB;
    const unsigned ldsw = (unsigned)wid * 1024u;
    const int aoff = lds_byte(wr * 64 + fr, fq * 8), boff = lds_byte(wc * 32 + fr, fq * 8);
    const char* const Abase = S.abase();
#define PG8_SA(b, h) (((b) * 2 + (h)) * HTB)
#define PG8_SB(b, h) ((4 + (b) * 2 + (h)) * HTB)
#define PG8_STAGE(bufoff, gbase, voff) do { _Pragma("unroll") for (int _i = 0; _i < 2; ++_i) \
        __builtin_amdgcn_global_load_lds((const unsigned*)((const char*)(gbase) + (voff)[_i]), (LAS unsigned*)(lds + (bufoff) + ldsw + _i * 8192), 16, 0, 0); } while (0)
#define PG8_RD(off) (*(const LAS i32x4*)(lds + (off)))
#define PG8_LDA(dst, b, h) do { _Pragma("unroll") for (int m = 0; m < 4; ++m) { if constexpr (F8) dst##8[m] = __builtin_shufflevector(PG8_RD(PG8_SA(b, h) + aoff + m * 2048), PG8_RD(PG8_SA(b, h) + aoff + m * 2048 + 1024), 0, 1, 2, 3, 4, 5, 6, 7); \
        else { _Pragma("unroll") for (int k = 0; k < 2; ++k) dst[m][k] = *(const LAS bf16x8*)(lds + PG8_SA(b, h) + aoff + m * 2048 + k * 1024); } } } while (0)
#define PG8_LDB(dst, b, h) do { _Pragma("unroll") for (int n = 0; n < 2; ++n) { if constexpr (F8) dst##8[n] = __builtin_shufflevector(PG8_RD(PG8_SB(b, h) + boff + n * 2048), PG8_RD(PG8_SB(b, h) + boff + n * 2048 + 1024), 0, 1, 2, 3, 4, 5, 6, 7); \
        else { _Pragma("unroll") for (int k = 0; k < 2; ++k) dst[n][k] = *(const LAS bf16x8*)(lds + PG8_SB(b, h) + boff + n * 2048 + k * 1024); } } } while (0)
#define PG8_MMA(ai, bj, At, Bt) do { __builtin_amdgcn_s_setprio(1); _Pragma("unroll") for (int m = 0; m < 4; ++m) _Pragma("unroll") for (int n = 0; n < 2; ++n) { \
        if constexpr (F8) asm volatile("v_mfma_scale_f32_16x16x128_f8f6f4 %0, %1, %2, %0, %3, %3 op_sel_hi:[0,0,0]" : "+v"(acc[ai][bj][m][n]) : "v"(Bt##8[n]), "v"(At##8[m]), "v"(sc1)); \
        else { _Pragma("unroll") for (int k = 0; k < 2; ++k) acc[ai][bj][m][n] = __builtin_amdgcn_mfma_f32_16x16x32_bf16(Bt[n][k], At[m][k], acc[ai][bj][m][n], 0, 0, 0); } } \
        __builtin_amdgcn_s_setprio(0); } while (0)
#define PG8_WAIT_V(n) asm volatile("s_waitcnt vmcnt(" #n ")" ::: "memory")
#define PG8_WAIT_L(n) asm volatile("s_waitcnt lgkmcnt(" #n ")" ::: "memory")
#define PG8_BAR __builtin_amdgcn_s_barrier()
#define PG8_SCHED __builtin_amdgcn_sched_barrier(0)
    Unit cur, nxt; int ui = 0;
    if (!S.next(0, cur)) return;
    bool has_next = S.next(1, nxt);
    unsigned ao[2][2], nao[2][2];
    { int t0[2][2] = {{0, 0}, {0, 0}}, t1[2][2] = {{0, 0}, {0, 0}}; S.aload(cur, R, C, t0); if (has_next) S.aload(nxt, R, C, t1); S.afin(cur, R, C, t0, ao);
      if (has_next) S.afin(nxt, R, C, t1, nao); else { nao[0][0] = ao[0][0]; nao[0][1] = ao[0][1]; nao[1][0] = ao[1][0]; nao[1][1] = ao[1][1]; } }
    asm volatile("" : "+v"(ao[0][0]), "+v"(ao[0][1]), "+v"(ao[1][0]), "+v"(ao[1][1]));
    asm volatile("" : "+v"(nao[0][0]), "+v"(nao[0][1]), "+v"(nao[1][0]), "+v"(nao[1][1]));
    f32x4 acc[2][2][4][2];
#pragma unroll
    for (int a = 0; a < 2; ++a)
#pragma unroll
        for (int b = 0; b < 2; ++b)
#pragma unroll
            for (int m = 0; m < 4; ++m)
#pragma unroll
                for (int n = 0; n < 2; ++n) acc[a][b][m][n] = (f32x4){0.f, 0.f, 0.f, 0.f};
    bf16x8 At[4][2], B0[2][2], B1[2][2]; i32x8 At8[4], B08[2], B18[2];
    int sc1 = 0x7F7F7F7F; asm volatile("" : "+v"(sc1));
    const char* cB = cur.B;
    PG8_STAGE(PG8_SB(0, 0), cB, voffB); PG8_STAGE(PG8_SB(0, 1), cB + hstep, voffB); PG8_STAGE(PG8_SA(0, 0), Abase, ao[0]); PG8_STAGE(PG8_SA(0, 1), Abase, ao[1]);
    if (wr == 1) PG8_BAR;
    PG8_WAIT_V(2); PG8_BAR;
    PG8_STAGE(PG8_SB(1, 0), cB + kstep, voffB); PG8_STAGE(PG8_SA(1, 0), Abase + kstep, ao[0]); PG8_STAGE(PG8_SB(1, 1), cB + hstep + kstep, voffB);
    PG8_WAIT_V(6); PG8_BAR;
    for (;;) {
        const char* nB = has_next ? nxt.B : cB;
        if constexpr (Epi::BIAS_LDS) {
            const float* bsrc = E.bias_src(cur, lane);
            __builtin_amdgcn_global_load_lds((const unsigned*)bsrc, (LAS unsigned*)(lds + LDS_BIAS + wid * 1024), 16, 0, 0);
        }
        if constexpr (Epi::RS_LDS) { if (wid == 0) __builtin_amdgcn_global_load_lds((const unsigned*)E.rs_src(cur, lane), (LAS unsigned*)(lds + LDS_RS), 16, 0, 0); }
#pragma unroll 1
        for (int t = 0; t < nt; t += 2) {
            const bool last = (t == nt - 2);
            const char* a1 = Abase + (size_t)(t + 1) * kstep;
            const char* a2 = last ? Abase : Abase + (size_t)(t + 2) * kstep; const char* b2 = last ? nB : cB + (size_t)(t + 2) * kstep;
            const char* a3 = a2 + kstep; const char* b3 = b2 + kstep;
            unsigned s2[2][2];
#pragma unroll
            for (int h = 0; h < 2; ++h)
#pragma unroll
                for (int i = 0; i < 2; ++i) s2[h][i] = last ? nao[h][i] : ao[h][i];
            PG8_LDB(B0, 0, 0); PG8_LDB(B1, 0, 1); PG8_SCHED; PG8_LDA(At, 0, 0); PG8_STAGE(PG8_SA(1, 1), a1, ao[1]);
            PG8_WAIT_V(8); PG8_WAIT_L(0); PG8_BAR; PG8_MMA(0, 0, At, B0); PG8_MMA(0, 1, At, B1); PG8_BAR; PG8_SCHED;
            PG8_LDA(At, 0, 1); PG8_STAGE(PG8_SB(0, 0), b2, voffB); PG8_STAGE(PG8_SB(0, 1), b2 + hstep, voffB); PG8_STAGE(PG8_SA(0, 0), a2, s2[0]);
            PG8_WAIT_V(8); PG8_WAIT_L(0); PG8_BAR; PG8_MMA(1, 0, At, B0); PG8_MMA(1, 1, At, B1); PG8_BAR; PG8_SCHED;
            PG8_LDB(B0, 1, 0); PG8_LDB(B1, 1, 1); PG8_SCHED; PG8_LDA(At, 1, 0); PG8_STAGE(PG8_SA(0, 1), a2, s2[1]);
            PG8_WAIT_V(8); PG8_WAIT_L(0); PG8_BAR; PG8_MMA(0, 0, At, B0); PG8_MMA(0, 1, At, B1); PG8_BAR; PG8_SCHED;
            PG8_LDA(At, 1, 1); PG8_STAGE(PG8_SB(1, 0), b3, voffB); PG8_STAGE(PG8_SB(1, 1), b3 + hstep, voffB); PG8_STAGE(PG8_SA(1, 0), a3, s2[0]);
            PG8_WAIT_V(8); PG8_WAIT_L(0); PG8_BAR; PG8_MMA(1, 0, At, B0); PG8_MMA(1, 1, At, B1); PG8_BAR; PG8_SCHED;
        }
        if (wr == 0) PG8_BAR;
        Unit nn; bool hn2 = false; int tk[2][2] = {{0, 0}, {0, 0}};
        if (has_next) { hn2 = S.next(ui + 2, nn); if (hn2) S.aload(nn, R, C, tk); }
        asm volatile("" ::: "memory");
        if constexpr (F8) asm volatile("s_nop 15\n\ts_nop 15" ::: "memory");
        { int fr_e = fr, fq_e = fq; asm volatile("" : "+v"(fr_e), "+v"(fq_e)); E(acc, cur, wr, wc, fr_e, fq_e); }
        if (!has_next) break;
#pragma unroll
        for (int a = 0; a < 2; ++a)
#pragma unroll
            for (int b = 0; b < 2; ++b)
#pragma unroll
                for (int m = 0; m < 4; ++m)
#pragma unroll
                    for (int n = 0; n < 2; ++n) acc[a][b][m][n] = (f32x4){0.f, 0.f, 0.f, 0.f};
        cur = nxt; cB = nB; ++ui;
#pragma unroll
        for (int h = 0; h < 2; ++h)
#pragma unroll
            for (int i = 0; i < 2; ++i) ao[h][i] = nao[h][i];
        has_next = hn2;
        if (has_next) { nxt = nn; S.afin(nxt, R, C, tk, nao); asm volatile("" : "+v"(nao[0][0]), "+v"(nao[0][1]), "+v"(nao[1][0]), "+v"(nao[1][1])); }
        if (wr == 1) PG8_BAR;
    }
    PG8_WAIT_V(0);
    PG8_BAR;
#undef PG8_SA
#undef PG8_SB
#undef PG8_STAGE
#undef PG8_LDA
#undef PG8_RD
#undef PG8_LDB
#undef PG8_MMA
#undef PG8_WAIT_V
#undef PG8_WAIT_L
#undef PG8_BAR
#undef PG8_SCHED
}

struct DenseSched {
    static constexpr int KB = 2048; static constexpr bool F8 = false;
    const char* A; const char* Bt; int nM, nN, nwg, G, c;
    __device__ __forceinline__ void init(const void* A_, const void* Bt_, int M, int N, int G_, int c_) { A = (const char*)A_; Bt = (const char*)Bt_; nM = M / BM; nN = N / BM; nwg = nM * nN; G = G_; c = c_; }
    __device__ __forceinline__ const char* abase() const { return A; }
    __device__ __forceinline__ bool next(int i, Unit& u) const {
        const long L = (long)i * G + c; if (L >= nwg) return false;
        int wgid = (int)L; { const int q = nwg / NXCD, r = nwg % NXCD, xcd = wgid % NXCD, off = wgid / NXCD; wgid = (xcd < r ? xcd * (q + 1) : r * (q + 1) + (xcd - r) * q) + off; }
        const int nig = WGM * nN, gid = wgid / nig, fm = gid * WGM, gsz = (nM - fm) < WGM ? (nM - fm) : WGM;
        const int pm = fm + ((wgid % nig) % gsz), pn = (wgid % nig) / gsz;
        u.B = Bt + (size_t)pn * BM * KB; u.dst = nullptr; u.row0 = pm * BM; u.nvalid = BM; u.pn = pn; u.e = 0; u.r0 = 0; u.cnt = 0; return true;
    }
    __device__ __forceinline__ void aload(const Unit&, const int (&)[2], const int (&)[2], int (&)[2][2]) const {}
    __device__ __forceinline__ void afin(const Unit& u, const int (&R)[2], const int (&C)[2], const int (&)[2][2], unsigned (&o)[2][2]) const {
#pragma unroll
        for (int h = 0; h < 2; ++h)
#pragma unroll
            for (int i = 0; i < 2; ++i) o[h][i] = (unsigned)((u.row0 + h * HALF + R[i]) * KB + C[i] * 2);
    }
};
}

struct EpiProj {
    static constexpr bool PERM = true, BIAS_LDS = false, RS_LDS = false;
    bf16* O; const float* rstd;
    __device__ __forceinline__ void operator()(const f32x4 (&acc)[2][2][4][2], const gg::Unit& u, int wr, int wc, int fr, int fq) const {
        const int row0 = u.row0 + wr * 64 + fr, col0 = u.pn * 256 + wc * 32 + 8 * fq;
#pragma unroll
        for (int ai = 0; ai < 2; ++ai)
#pragma unroll
            for (int m = 0; m < 4; ++m) { bf16* rowp = O + (size_t)(row0 + ai * 128 + m * 16) * INC + col0; const float rs = rstd[row0 + ai * 128 + m * 16];
#pragma unroll
                for (int bj = 0; bj < 2; ++bj) { const f32x4 v0 = acc[ai][bj][m][0] * rs, v1 = acc[ai][bj][m][1] * rs;
                    v4u w; w.x = gg::cvt_pk_bf16(v0[0], v0[1]); w.y = gg::cvt_pk_bf16(v0[2], v0[3]); w.z = gg::cvt_pk_bf16(v1[0], v1[1]); w.w = gg::cvt_pk_bf16(v1[2], v1[3]);
                    *(v4u*)(rowp + bj * 128) = w; } }
    }
};
struct EpiX1 {
    static constexpr bool PERM = true, BIAS_LDS = false, RS_LDS = false;
    const bf16* X; bf16* O;
    __device__ __forceinline__ void operator()(const f32x4 (&acc)[2][2][4][2], const gg::Unit& u, int wr, int wc, int fr, int fq) const {
        const int row0 = u.row0 + wr * 64 + fr, col0 = u.pn * 256 + wc * 32 + 8 * fq;
#pragma unroll
        for (int ai = 0; ai < 2; ++ai)
#pragma unroll
            for (int m = 0; m < 4; ++m) { const size_t off = (size_t)(row0 + ai * 128 + m * 16) * D + col0;
#pragma unroll
                for (int bj = 0; bj < 2; ++bj) { const v4u xw = *(const v4u*)(X + off + bj * 128);
                    const f32x4 v0 = acc[ai][bj][m][0] + (f32x4){__uint_as_float(xw.x << 16), __uint_as_float(xw.x & 0xffff0000u), __uint_as_float(xw.y << 16), __uint_as_float(xw.y & 0xffff0000u)};
                    const f32x4 v1 = acc[ai][bj][m][1] + (f32x4){__uint_as_float(xw.z << 16), __uint_as_float(xw.z & 0xffff0000u), __uint_as_float(xw.w << 16), __uint_as_float(xw.w & 0xffff0000u)};
                    v4u w; w.x = pk2(v0[0], v0[1]); w.y = pk2(v0[2], v0[3]); w.z = pk2(v1[0], v1[1]); w.w = pk2(v1[2], v1[3]);
                    *(v4u*)(O + off + bj * 128) = w; } }
    }
};

__device__ __forceinline__ void staggered_conv(const Params& p, Frame& F, CvJob& cv, int n) { if (n > 0) { cv.run(p, F.lds + F.wave * CV_LDS, F.lane, n); } __syncthreads(); }
__device__ __forceinline__ void phase_inproj(const Params& p, Frame& F) {
    const int g = (F.bid >> 3) & 3; const int per = (CV_WGU + F.NGW - 1) / F.NGW;
    const int pre = (per * g + 1) / 3;
    CvJob cv; cv.init(0, F.gw, F.NGW, CV_WGU);
    staggered_conv(p, F, cv, pre);
    gg::DenseSched S; S.init(p.ws + WS_XN, p.ws + WS_WINT, NTOK, INC, F.G, F.bid);
    EpiProj E{(bf16*)(p.ws + WS_PROJ), (const float*)(p.ws + WS_RSTD1)};
    gg::gemm_phase<gg::DenseSched, EpiProj>(F.lds, S, E);
    __syncthreads();
    cv.rest(p, F.lds + F.wave * CV_LDS, F.lane);
}
__device__ __forceinline__ void phase_outproj(const Params& p, Frame& F) {
    const int g = (F.bid >> 3) & 3; const int per = (CV_WD_A + F.NGW - 1) / F.NGW;
    const int pre = (per * g + 1) / 3;
    CvJob cv; cv.init(2, F.gw, F.NGW, CV_WD_A);
    staggered_conv(p, F, cv, pre);
    gg::DenseSched S; S.init(p.ws + WS_MIX, p.ws + WS_WOUTT, NTOK, D, F.G, F.bid);
    EpiX1 E{(const bf16*)(p.ws + WS_XN), (bf16*)(p.ws + WS_X1B)};
    gg::gemm_phase<gg::DenseSched, EpiX1>(F.lds, S, E);
    __syncthreads();
    cv.rest(p, F.lds + F.wave * CV_LDS, F.lane);
}

__device__ __forceinline__ void load_tables(const Params& p, Frame& F, LAS int* sb) {
    unsigned* ctl = (unsigned*)(p.ws + WS_CTL);
    __syncthreads();
    if (F.tid < NE) sb[700 + F.tid] = (int)__hip_atomic_load(ctl + CW_CNT + 64 * F.tid, __ATOMIC_RELAXED, __HIP_MEMORY_SCOPE_AGENT);
    __syncthreads();
    if (F.tid == 0) {
        int acc = 0, tacc = 0;
        for (int e = 0; e < NE; ++e) { const int c = sb[700 + e]; sb[e] = acc; sb[64 + e] = tacc; acc += c; tacc += (c + 255) / 256; }
        sb[NE] = acc; sb[64 + NE] = tacc;
    }
    __syncthreads();
    { const int ntile = sb[64 + NE]; for (int t = F.tid; t < ntile; t += NTHREADS) { int e = 0;
#pragma unroll
        for (int st = 16; st > 0; st >>= 1) if (sb[64 + e + st] <= t) e += st;
        sb[128 + t] = e; } }
    __syncthreads();
}
__device__ __forceinline__ int lds_s(LAS const int* q) { return __builtin_amdgcn_readfirstlane(*q); }

template <int NCT, bool GATHER> struct MoeSched {
    static constexpr int KB = 1024; static constexpr bool F8 = true;
    const char* A; const char* W; const int* list; LAS const int* sb; int T, TPX, PX, x, j; unsigned char* dstbase; int dpitch;
    __device__ __forceinline__ void init(LAS const int* sb_, const Frame& F) { sb = sb_; T = lds_s(sb + 64 + NE); const int nx = (F.G % 8 == 0) ? 8 : 1; PX = F.G / nx; TPX = (T + nx - 1) / nx;
        const int c = (nx == 8) ? (F.bid % 8) * PX + F.bid / 8 : F.bid; x = c / PX; j = c % PX; }
    __device__ __forceinline__ int rounds() const { return (TPX * NCT + PX - 1) / PX; }
    __device__ __forceinline__ int rem() const { return (TPX * NCT) % PX; }
    __device__ __forceinline__ const char* abase() const { return A; }
    __device__ __forceinline__ bool next(int i, gg::Unit& u) const {
        const int m = i * PX + j, tl = m / NCT, ct = m % NCT, t = x * TPX + tl; if (tl >= TPX || t >= T) return false;
        const int e = lds_s(sb + 128 + t);
        const int base = lds_s(sb + e), cnt = lds_s(sb + e + 1) - base, r0 = (t - lds_s(sb + 64 + e)) * 256;
        u.B = W + (size_t)(e * NCT + ct) * 256 * KB; u.pn = ct; u.e = e; u.r0 = r0; u.cnt = cnt; u.row0 = base + r0; u.nvalid = (cnt - r0) < 256 ? (cnt - r0) : 256;
        u.dst = dstbase + (size_t)u.row0 * dpitch;
        return true;
    }
    __device__ __forceinline__ void aload(const gg::Unit& u, const int (&R)[2], const int (&C)[2], int (&tk)[2][2]) const {
        if (GATHER) {
#pragma unroll
            for (int h = 0; h < 2; ++h)
#pragma unroll
                for (int i = 0; i < 2; ++i) { int r = u.r0 + h * 128 + R[i]; if (r >= u.cnt) r = 0; tk[h][i] = list[u.e * NTOK + r]; }
        }
    }
    __device__ __forceinline__ void afin(const gg::Unit& u, const int (&R)[2], const int (&C)[2], const int (&tk)[2][2], unsigned (&o)[2][2]) const {
#pragma unroll
        for (int h = 0; h < 2; ++h)
#pragma unroll
            for (int i = 0; i < 2; ++i) {
                if (GATHER) o[h][i] = (unsigned)(tk[h][i] * KB + C[i] * 2);
                else o[h][i] = (unsigned)((u.row0 + h * 128 + R[i]) * KB + C[i] * 2);
            }
    }
};
#define EPI_LDS_SYNC() do { asm volatile("s_waitcnt lgkmcnt(0)" ::: "memory"); __builtin_amdgcn_s_barrier(); asm volatile("" ::: "memory"); } while (0)
__device__ __forceinline__ void ob_flush(LAS unsigned char* ob, unsigned char* dst, int rbase, int nvalid, int dpitch, int colbyte, int tid) {
#pragma unroll
    for (int hh = 0; hh < 2; ++hh) { const int row = hh * 64 + (tid >> 3), c16 = tid & 7; const v4u x = *(const LAS v4u*)(ob + row * OB_PITCH + c16 * 16);
        if (rbase + row < nvalid) *(v4u*)(dst + (unsigned)((rbase + row) * dpitch + colbyte + c16 * 16)) = x; }
}
struct EpiAct {
    static constexpr bool PERM = true, BIAS_LDS = true, RS_LDS = true;
    const float* bg; const float* bu; const float* rs; LAS unsigned char* ob; LAS unsigned char* bl; LAS unsigned char* rl;
    __device__ __forceinline__ const float* bias_src(const gg::Unit& u, int lane) const { return (lane < 32 ? bg : bu) + u.e * FF + u.pn * 128 + 4 * (lane & 31); }
    __device__ __forceinline__ const float* rs_src(const gg::Unit& u, int lane) const { return rs + (size_t)u.e * NTOK + u.r0 + 4 * lane; }
    __device__ __forceinline__ void operator()(const f32x4 (&acc)[2][2][4][2], const gg::Unit& u, int wr, int wc, int fr, int fq) const {
        const int tid = (wr * 4 + wc) * 64 + fq * 16 + fr;
        const LAS float* bs = (const LAS float*)(bl + (wr * 4 + wc) * 1024) + wc * 32 + 8 * fq;
        const f32x4 g0 = *(const LAS f32x4*)bs, g1 = *(const LAS f32x4*)(bs + 4), u0p = *(const LAS f32x4*)(bs + 128) + 1.0f, u1p = *(const LAS f32x4*)(bs + 132) + 1.0f;
        float rsv[2][4];
#pragma unroll
        for (int ai = 0; ai < 2; ++ai)
#pragma unroll
            for (int m = 0; m < 4; ++m) rsv[ai][m] = *((const LAS float*)rl + ai * 128 + wr * 64 + m * 16 + fr) * WINV;
#pragma unroll
        for (int ai = 0; ai < 2; ++ai) {
#pragma unroll
            for (int m = 0; m < 4; ++m) {
                const float sc = rsv[ai][m];
                float r[8];
#pragma unroll
                for (int n = 0; n < 2; ++n) { const f32x4 av = acc[ai][0][m][n], uv = acc[ai][1][m][n], gb4 = n ? g1 : g0, ub4 = n ? u1p : u0p;
#pragma unroll
                    for (int h = 0; h < 2; ++h) {
                        const hg2 a2 = {av[2 * h], av[2 * h + 1]}, u2 = {uv[2 * h], uv[2 * h + 1]}, gb = {gb4[2 * h], gb4[2 * h + 1]}, ub = {ub4[2 * h], ub4[2 * h + 1]};
                        hg2 gt = a2 * sc + gb; gt.x = fminf(gt.x, 7.0f); gt.y = fminf(gt.y, 7.0f);
                        const hg2 ea = gt * (-2.4554669595930157f);
                        hg2 den; den.x = ex2f_(ea.x); den.y = ex2f_(ea.y); den = den + 1.0f;
                        hg2 rc; rc.x = rcpf_(den.x); rc.y = rcpf_(den.y);
                        hg2 up1 = u2 * sc + ub;
                        up1.x = __builtin_amdgcn_fmed3f(up1.x, -6.0f, 8.0f); up1.y = __builtin_amdgcn_fmed3f(up1.y, -6.0f, 8.0f);
                        const hg2 rr = up1 * (gt * rc);
                        r[4 * n + 2 * h] = rr.x; r[4 * n + 2 * h + 1] = rr.y; } }
                v2u w; w.x = pk4_fp8(r[0], r[1], r[2], r[3]); w.y = pk4_fp8(r[4], r[5], r[6], r[7]);
                *(LAS v2u*)(ob + (wr * 64 + m * 16 + fr) * OB_PITCH + wc * 32 + 8 * fq) = w; }
            EPI_LDS_SYNC();
            ob_flush(ob, u.dst, ai * 128, u.nvalid, FF, u.pn * 128, tid);
            if (ai == 0) EPI_LDS_SYNC();
        }
    }
};
struct EpiDown {
    static constexpr bool PERM = true, BIAS_LDS = true, RS_LDS = false;
    const float* bd; LAS unsigned char* ob; LAS unsigned char* bl;
    __device__ __forceinline__ const float* bias_src(const gg::Unit& u, int lane) const { return bd + u.e * D + u.pn * 256 + 4 * lane; }
    __device__ __forceinline__ void operator()(const f32x4 (&acc)[2][2][4][2], const gg::Unit& u, int wr, int wc, int fr, int fq) const {
        const int tid = (wr * 4 + wc) * 64 + fq * 16 + fr;
        const LAS float* bs = (const LAS float*)(bl + (wr * 4 + wc) * 1024) + wc * 32 + 8 * fq;
        f32x4 bv[2][2];
#pragma unroll
        for (int bj = 0; bj < 2; ++bj) { bv[bj][0] = *(const LAS f32x4*)(bs + bj * 128); bv[bj][1] = *(const LAS f32x4*)(bs + bj * 128 + 4); }
#pragma unroll
        for (int ai = 0; ai < 2; ++ai)
#pragma unroll
            for (int bj = 0; bj < 2; ++bj) {
#pragma unroll
                for (int m = 0; m < 4; ++m) { const f32x4 v0 = acc[ai][bj][m][0] * WINV + bv[bj][0], v1 = acc[ai][bj][m][1] * WINV + bv[bj][1];
                    v2u w; w.x = pk4_fp8(v0[0], v0[1], v0[2], v0[3]); w.y = pk4_fp8(v1[0], v1[1], v1[2], v1[3]);
                    *(LAS v2u*)(ob + (wr * 64 + m * 16 + fr) * OB_PITCH + wc * 32 + 8 * fq) = w; }
                EPI_LDS_SYNC();
                ob_flush(ob, u.dst, ai * 128, u.nvalid, D, u.pn * 256 + bj * 128, tid);
                if (!(ai == 1 && bj == 1)) EPI_LDS_SYNC();
            }
    }
};
__device__ __forceinline__ int vcu_of(const Frame& F) { return (F.G % 8 == 0) ? (F.bid % 8) * (F.G / 8) + F.bid / 8 : F.bid; }
__device__ __forceinline__ void phase_gateup(const Params& p, Frame& F) {
    LAS int* sb = (LAS int*)(F.lds + LDS_TAB); load_tables(p, F, sb);
    MoeSched<8, true> S; S.A = (const char*)(p.ws + WS_H8); S.W = (const char*)(p.ws + WS_WGU8); S.list = (const int*)(p.ws + WS_LIST); S.init(sb, F);
    S.dstbase = p.ws + WS_ACT8; S.dpitch = FF;
    EpiAct E{p.b_gate, p.b_up, (const float*)(p.ws + WS_RS), F.lds + LDS_OB, F.lds + LDS_BIAS, F.lds + LDS_RS};
    gg::gemm_phase<MoeSched<8, true>, EpiAct>(F.lds, S, E);
    {
        const int rem = S.rem(), per = rem ? S.PX - rem : 0, nidle = per * (F.G / S.PX);
        __syncthreads();
        CvJob cv;
        if (nidle >= 64) { if (S.j >= rem) { cv.init(2, CV_WD_A + (S.x * per + S.j - rem) * NWAVES + F.wave, nidle * NWAVES, CV_WD); cv.rest(p, F.lds + F.wave * CV_LDS, F.lane); } }
        else { cv.init(2, CV_WD_A + F.gw, F.NGW, CV_WD); cv.rest(p, F.lds + F.wave * CV_LDS, F.lane); }
    }
}
__device__ __forceinline__ void phase_down(const Params& p, Frame& F) {
    LAS int* sb = (LAS int*)(F.lds + LDS_TAB); if (p.ph_lo > 6) load_tables(p, F, sb);
    MoeSched<4, false> S; S.A = (const char*)(p.ws + WS_ACT8); S.W = (const char*)(p.ws + WS_WD8); S.list = nullptr; S.init(sb, F);
    S.dstbase = p.ws + WS_YS; S.dpitch = D;
    EpiDown E{p.b_down, F.lds + LDS_OB, F.lds + LDS_BIAS};
    gg::gemm_phase<MoeSched<4, false>, EpiDown>(F.lds, S, E);
}

namespace hg {
constexpr int LDK = 136, LDS_ = 72, LDO = 132;
constexpr int OFF_ST = 0, OFF_QD = OFF_ST + 128 * LDK * 2, OFF_QP = OFF_QD + 64 * LDK * 2, OFF_KP = OFF_QP + 64 * LDK * 2, OFF_KDT = OFF_KP + 64 * LDK * 2,
              OFF_VT = OFF_KDT + 128 * LDS_ * 2, OFF_P = OFF_VT + 128 * LDS_ * 2, OFF_TOT = OFF_P + 64 * LDS_ * 2, OFF_DV = OFF_TOT + 4096, OFF_SQW = OFF_DV + 512, OFF_END = OFF_SQW + 2048, OFF_O = OFF_QD;
static_assert(64 * LDO * 4 <= 2 * 64 * LDK * 2 && OFF_END <= 140000, "hgrn LDS map");
typedef float f32x2 __attribute__((ext_vector_type(2)));
#define HG_LDF(off) (*(const LAS bf16x8*)(lds + (off)))
__device__ __forceinline__ f32x2 unpk2(unsigned raw) { return (f32x2){__uint_as_float(raw << 16), __uint_as_float(raw & 0xffff0000u)}; }
__device__ __forceinline__ f32x2 ex2v(f32x2 v) { return (f32x2){ex2f_(v.x), ex2f_(v.y)}; }
__device__ __forceinline__ f32x2 lg2v(f32x2 v) { return (f32x2){lg2f_(v.x), lg2f_(v.y)}; }
__device__ __forceinline__ f32x2 rcpv(f32x2 v) { return (f32x2){rcpf_(v.x), rcpf_(v.y)}; }
__device__ __forceinline__ f32x2 min2(f32x2 v, float c) { return (f32x2){fminf(v.x, c), fminf(v.y, c)}; }
__device__ __forceinline__ f32x2 sig2(f32x2 z) { return rcpv(ex2v(z * (-1.4426950408889634f)) + 1.0f); }
__device__ __forceinline__ unsigned pk2v(f32x2 v) { return pk2(v.x, v.y); }

template <bool PASS_B>
__device__ __forceinline__ void hgrn_unit(const Params& p, Frame& F, int unit, CvJob* cv) {
    LAS unsigned char* lds = F.lds;
    const bf16* PROJ = (const bf16*)(p.ws + WS_PROJ); bf16* MIX = (bf16*)(p.ws + WS_MIX);
    float* HST = (float*)(p.ws + WS_HST); float* HDEC = (float*)(p.ws + WS_HDEC);
    const int b = unit >> 6, h = (unit >> 4) & 3, seg = unit & 15;
    const int lane = F.lane, w = F.wave, fr = lane & 15, q = lane >> 4, cp = lane, tg = w;
    const int ch = h * HD + 2 * cp;
    f32x2 lb2; { const float a0 = p.hgrn_lb[ch], a1 = p.hgrn_lb[HW + ch], c0 = p.hgrn_lb[ch + 1], c1 = p.hgrn_lb[HW + ch + 1]; lb2.x = rcpf_(1.0f + __expf(a1 - a0)); lb2.y = rcpf_(1.0f + __expf(c1 - c0)); }
    const f32x2 oml2 = 1.0f - lb2;
    const f32x2 ng2 = {p.hgrn_norm_g[2 * cp], p.hgrn_norm_g[2 * cp + 1]};
    f32x4 acc_s[8];
#pragma unroll
    for (int kt = 0; kt < 8; ++kt) acc_s[kt] = (f32x4){0.f, 0.f, 0.f, 0.f};
    f32x2 segsum2 = {0.f, 0.f};
    unsigned nq[8], nf[8], nv[8], ngr[8];
    if (PASS_B) { const bf16* base = PROJ + (size_t)(b * SEQ + seg * 512 + 8 * tg) * INC + ch;
#pragma unroll
      for (int i = 0; i < 8; ++i) { const bf16* r = base + (size_t)i * INC; nf[i] = *(const unsigned*)(r + HW); nv[i] = *(const unsigned*)(r + 2 * HW); nq[i] = *(const unsigned*)r; ngr[i] = *(const unsigned*)(r + 3 * HW); } }
    if (PASS_B) {
        LAS float* Wt = (LAS float*)(lds + OFF_QD);
        if (F.tid < 128) { float dv[15];
#pragma unroll
            for (int j = 0; j < 15; ++j) dv[j] = (j < seg) ? HDEC[(unit - seg + j) * 128 + F.tid] : 1.0f;
            float run = 1.0f;
#pragma unroll
            for (int j = 14; j >= 0; --j) if (j < seg) { Wt[j * 128 + F.tid] = run; run *= dv[j]; } }
        LDS_SYNC();
        for (int j0 = 0; j0 < seg; j0 += 5) {
            v4u e4[5][4];
#pragma unroll
            for (int u = 0; u < 5; ++u) { const int j = (j0 + u < seg) ? j0 + u : seg - 1; const unsigned char* hs = (const unsigned char*)HST + (size_t)(unit - seg + j) * 32768 + (size_t)w * 4096 + lane * 16;
#pragma unroll
                for (int kp = 0; kp < 4; ++kp) e4[u][kp] = *(const v4u*)(hs + kp * 1024); }
#pragma unroll
            for (int u = 0; u < 5; ++u) { const bool ok = j0 + u < seg; const int j = ok ? j0 + u : seg - 1;
#pragma unroll
                for (int kt = 0; kt < 8; ++kt) { f32x4 w4 = *(const LAS f32x4*)(Wt + j * 128 + 16 * kt + 4 * q); if (!ok) w4 = (f32x4){0.f, 0.f, 0.f, 0.f};
                    const unsigned r0 = (kt & 1) ? e4[u][kt >> 1].z : e4[u][kt >> 1].x, r1 = (kt & 1) ? e4[u][kt >> 1].w : e4[u][kt >> 1].y;
                    const f32x4 ev = {__uint_as_float(r0 << 16), __uint_as_float(r0 & 0xffff0000u), __uint_as_float(r1 << 16), __uint_as_float(r1 & 0xffff0000u)};
                    acc_s[kt] = acc_s[kt] + w4 * ev; } } }
        LDS_SYNC();
#pragma unroll
        for (int kt = 0; kt < 8; ++kt) { v2u wv; wv.x = pk2(acc_s[kt][0], acc_s[kt][1]); wv.y = pk2(acc_s[kt][2], acc_s[kt][3]); *(LAS v2u*)(lds + OFF_ST + ((16 * w + fr) * LDK + 16 * kt + 4 * q) * 2) = wv; }
    }
    for (int c = 0; c < 8; ++c) {
        const int row0 = b * SEQ + seg * 512 + c * 64 + 8 * tg;
        unsigned qraw[8], fraw[8], vraw[8], graw[8];
        if (PASS_B) {
#pragma unroll
            for (int i = 0; i < 8; ++i) { qraw[i] = nq[i]; fraw[i] = nf[i]; vraw[i] = nv[i]; graw[i] = ngr[i]; }
            if (c < 7) { const bf16* base = PROJ + (size_t)(row0 + 64) * INC + ch;
#pragma unroll
                for (int i = 0; i < 8; ++i) { const bf16* r = base + (size_t)i * INC; nf[i] = *(const unsigned*)(r + HW); nv[i] = *(const unsigned*)(r + 2 * HW); nq[i] = *(const unsigned*)r; ngr[i] = *(const unsigned*)(r + 3 * HW); } }
        } else {
            const bf16* base = PROJ + (size_t)row0 * INC + ch;
#pragma unroll
            for (int i = 0; i < 8; ++i) { const bf16* r = base + (size_t)i * INC; fraw[i] = *(const unsigned*)(r + HW); vraw[i] = *(const unsigned*)(r + 2 * HW); qraw[i] = 0u; graw[i] = 0u; }
#pragma unroll
            for (int i = 0; i < 8; ++i) asm volatile("" : "+v"(fraw[i]), "+v"(vraw[i]));
            if (cv) cv->top(p, lane);
        }
        f32x2 k2[8], b2[8];
        { f32x2 s2 = {0.f, 0.f};
#pragma unroll
          for (int i = 0; i < 8; ++i) { const f32x2 f2 = lb2 + oml2 * sig2(unpk2(fraw[i])); k2[i] = 1.0f - f2; s2 += lg2v(f2); b2[i] = s2; }
          *(LAS f32x2*)(lds + OFF_TOT + (tg * 128 + 2 * cp) * 4) = s2; }
        LDS_SYNC();
        f32x2 off2 = {0.f, 0.f}, bl2 = {0.f, 0.f}, bm2 = {0.f, 0.f};
#pragma unroll
        for (int g = 0; g < 8; ++g) { const f32x2 t2 = *(const LAS f32x2*)(lds + OFF_TOT + (g * 128 + 2 * cp) * 4); if (g < tg) off2 += t2; if (g < 4) bm2 += t2; bl2 += t2; }
        segsum2 += bl2;
        if (tg == 0) *(LAS f32x2*)(lds + OFF_DV + 2 * cp * 4) = ex2v(bl2);
        const f32x2 cq2 = ex2v(bm2), ck2 = ex2v(bl2 - bm2);
        { unsigned kd0[8], kd1[8], vv0[8], vv1[8];
#pragma unroll
          for (int i = 0; i < 8; ++i) { const f32x2 bb2 = off2 + b2[i];
              vv0[i] = vraw[i] & 0xffffu; vv1[i] = vraw[i] >> 16;
              unsigned kk;
              if (PASS_B) { const f32x2 qp = unpk2(qraw[i]); const f32x2 q2 = qp * sig2(qp);
                  const int t = 8 * tg + i;
                  const f32x2 qe = q2 * ex2v(min2(bb2 - bm2, 115.f)), ke = k2[i] * ex2v(min2(bm2 - bb2, 115.f));
                  *(LAS unsigned*)(lds + OFF_QD + (t * LDK + 2 * cp) * 2) = pk2v(qe * cq2);
                  *(LAS unsigned*)(lds + OFF_QP + (t * LDK + 2 * cp) * 2) = pk2v(qe);
                  *(LAS unsigned*)(lds + OFF_KP + (t * LDK + 2 * cp) * 2) = pk2v(ke);
                  kk = pk2v(ke * ck2); }
              else kk = pk2v(k2[i] * ex2v(bl2 - bb2));
              kd0[i] = kk & 0xffffu; kd1[i] = kk >> 16; }
          v4u x; x.x = kd0[0] | (kd0[1] << 16); x.y = kd0[2] | (kd0[3] << 16); x.z = kd0[4] | (kd0[5] << 16); x.w = kd0[6] | (kd0[7] << 16); *(LAS v4u*)(lds + OFF_KDT + ((2 * cp) * LDS_ + 8 * tg) * 2) = x;
          x.x = kd1[0] | (kd1[1] << 16); x.y = kd1[2] | (kd1[3] << 16); x.z = kd1[4] | (kd1[5] << 16); x.w = kd1[6] | (kd1[7] << 16); *(LAS v4u*)(lds + OFF_KDT + ((2 * cp + 1) * LDS_ + 8 * tg) * 2) = x;
          x.x = vv0[0] | (vv0[1] << 16); x.y = vv0[2] | (vv0[3] << 16); x.z = vv0[4] | (vv0[5] << 16); x.w = vv0[6] | (vv0[7] << 16); *(LAS v4u*)(lds + OFF_VT + ((2 * cp) * LDS_ + 8 * tg) * 2) = x;
          x.x = vv1[0] | (vv1[1] << 16); x.y = vv1[2] | (vv1[3] << 16); x.z = vv1[4] | (vv1[5] << 16); x.w = vv1[6] | (vv1[7] << 16); *(LAS v4u*)(lds + OFF_VT + ((2 * cp + 1) * LDS_ + 8 * tg) * 2) = x; }
        LDS_SYNC();
        f32x4 acc_o[4];
        if (PASS_B) {
#pragma unroll
            for (int ti = 0; ti < 4; ++ti) acc_o[ti] = (f32x4){0.f, 0.f, 0.f, 0.f};
#pragma unroll
            for (int ks = 0; ks < 4; ++ks) { const bf16x8 a = HG_LDF(OFF_ST + ((16 * w + fr) * LDK + 32 * ks + 8 * q) * 2);
#pragma unroll
                for (int ti = 0; ti < 4; ++ti) { const bf16x8 bq = HG_LDF(OFF_QD + ((16 * ti + fr) * LDK + 32 * ks + 8 * q) * 2); acc_o[ti] = __builtin_amdgcn_mfma_f32_16x16x32_bf16(a, bq, acc_o[ti], 0, 0, 0); } }
            { const int ti = w >> 1;
#pragma unroll
              for (int sj = 0; sj < 2; ++sj) { const int si = 2 * (w & 1) + sj; f32x4 ap = (f32x4){0.f, 0.f, 0.f, 0.f};
                  if (si <= ti) {
#pragma unroll
                      for (int ks = 0; ks < 4; ++ks) { const bf16x8 a = HG_LDF(OFF_KP + ((16 * si + fr) * LDK + 32 * ks + 8 * q) * 2), bq = HG_LDF(OFF_QP + ((16 * ti + fr) * LDK + 32 * ks + 8 * q) * 2);
                          ap = __builtin_amdgcn_mfma_f32_16x16x32_bf16(a, bq, ap, 0, 0, 0); } }
                  const int t = 16 * ti + fr, s0 = 16 * si + 4 * q;
                  const float p0 = (si <= ti && s0 + 0 <= t) ? ap[0] : 0.f, p1 = (si <= ti && s0 + 1 <= t) ? ap[1] : 0.f, p2 = (si <= ti && s0 + 2 <= t) ? ap[2] : 0.f, p3 = (si <= ti && s0 + 3 <= t) ? ap[3] : 0.f;
                  v2u wv; wv.x = pk2(p0, p1); wv.y = pk2(p2, p3); *(LAS v2u*)(lds + OFF_P + (t * LDS_ + s0) * 2) = wv; } }
            LDS_SYNC();
        }
        { bf16x8 vt[2];
#pragma unroll
          for (int ss = 0; ss < 2; ++ss) vt[ss] = HG_LDF(OFF_VT + ((16 * w + fr) * LDS_ + 32 * ss + 8 * q) * 2);
          if (PASS_B) {
#pragma unroll
              for (int ss = 0; ss < 2; ++ss)
#pragma unroll
                  for (int ti = 0; ti < 4; ++ti) { if (ss == 1 && ti < 2) continue; const bf16x8 bp = HG_LDF(OFF_P + ((16 * ti + fr) * LDS_ + 32 * ss + 8 * q) * 2); acc_o[ti] = __builtin_amdgcn_mfma_f32_16x16x32_bf16(vt[ss], bp, acc_o[ti], 0, 0, 0); }
          }
#pragma unroll
          for (int kt = 0; kt < 8; ++kt) { const f32x4 d4 = *(const LAS f32x4*)(lds + OFF_DV + (16 * kt + 4 * q) * 4); acc_s[kt] = acc_s[kt] * d4;
#pragma unroll
              for (int ss = 0; ss < 2; ++ss) { const bf16x8 a = HG_LDF(OFF_KDT + ((16 * kt + fr) * LDS_ + 32 * ss + 8 * q) * 2); acc_s[kt] = __builtin_amdgcn_mfma_f32_16x16x32_bf16(a, vt[ss], acc_s[kt], 0, 0, 0); } }
        }
        if (PASS_B) {
#pragma unroll
            for (int ti = 0; ti < 4; ++ti) { *(LAS f32x4*)(lds + OFF_O + ((16 * ti + fr) * LDO + 16 * w + 4 * q) * 4) = acc_o[ti];
                float sq = (acc_o[ti][0] * acc_o[ti][0] + acc_o[ti][1] * acc_o[ti][1]) + (acc_o[ti][2] * acc_o[ti][2] + acc_o[ti][3] * acc_o[ti][3]);
                sq += __shfl_xor(sq, 16); sq += __shfl_xor(sq, 32);
                if (q == 0) *(LAS float*)(lds + OFF_SQW + ((16 * ti + fr) * 8 + w) * 4) = sq; }
#pragma unroll
            for (int kt = 0; kt < 8; ++kt) { v2u wv; wv.x = pk2(acc_s[kt][0], acc_s[kt][1]); wv.y = pk2(acc_s[kt][2], acc_s[kt][3]); *(LAS v2u*)(lds + OFF_ST + ((16 * w + fr) * LDK + 16 * kt + 4 * q) * 2) = wv; }
            LDS_SYNC();
#pragma unroll
            for (int i = 0; i < 8; ++i) { const int t = 8 * tg + i; const f32x2 o2 = *(const LAS f32x2*)(lds + OFF_O + (t * LDO + 2 * cp) * 4);
                const f32x4 sa = *(const LAS f32x4*)(lds + OFF_SQW + t * 32), sb4 = *(const LAS f32x4*)(lds + OFF_SQW + t * 32 + 16);
                const float ss = ((sa[0] + sa[1]) + (sa[2] + sa[3])) + ((sb4[0] + sb4[1]) + (sb4[2] + sb4[3])); const float rstd = rsqf_(ss * (1.0f / HD) + EPS);
                const f32x2 gv = unpk2(graw[i]);
                *(unsigned*)(MIX + (size_t)(row0 + i) * D + ch) = pk2v(o2 * rstd * ng2 * (gv * sig2(gv))); }
        }
        if (!PASS_B && cv) cv->bottom(lds + OFF_ST + w * CV_LDS, lane);
    }
    if (!PASS_B) {
        unsigned char* hs = (unsigned char*)HST + (size_t)unit * 32768 + (size_t)w * 4096 + lane * 16;
#pragma unroll
        for (int kp = 0; kp < 4; ++kp) { v4u wv; wv.x = pk2(acc_s[2 * kp][0], acc_s[2 * kp][1]); wv.y = pk2(acc_s[2 * kp][2], acc_s[2 * kp][3]); wv.z = pk2(acc_s[2 * kp + 1][0], acc_s[2 * kp + 1][1]); wv.w = pk2(acc_s[2 * kp + 1][2], acc_s[2 * kp + 1][3]);
            *(v4u*)(hs + kp * 1024) = wv; }
        if (tg == 0) *(f32x2*)(HDEC + unit * 128 + 2 * cp) = ex2v(segsum2);
    }
    LDS_SYNC();
}

__device__ __forceinline__ void pool_unit(const Params& p, Frame& F, int unit) {
    LAS unsigned char* lds = F.lds;
    const bf16* PROJ = (const bf16*)(p.ws + WS_PROJ); bf16* MIX = (bf16*)(p.ws + WS_MIX); const bf16* POOLT = (const bf16*)(p.ws + WS_POOLT);
    const int lane = F.lane, w = F.wave, fr = lane & 15, q = lane >> 4, cp = lane, tg = w;
    const int tok0 = unit * 64, t0 = tok0 + 8 * tg, s0 = t0 % SEQ;
#pragma unroll
    for (int g = 0; g < 4; ++g) {
        constexpr int dummy = 0; (void)dummy;
        const int win = 2 << g;
        const bf16* col = PROJ + (size_t)t0 * INC + 4 * HW + g * 128 + 2 * cp;
        float u0[23], u1[23];
#pragma unroll
        for (int j = 0; j < 23; ++j) { if (j < 8 + win - 1) { const int rel = j - (win - 1); unsigned raw = 0u; if (s0 + rel >= 0) raw = *(const unsigned*)(col + (ptrdiff_t)rel * INC); u0[j] = bf2f(raw & 0xffffu); u1[j] = bf2f(raw >> 16); } else { u0[j] = 0.f; u1[j] = 0.f; } }
#pragma unroll
        for (int i = 0; i < 8; ++i) { float a0 = 0.f, a1 = 0.f;
#pragma unroll
            for (int jj = 0; jj < 16; ++jj) if (jj < win) { a0 += u0[i + jj]; a1 += u1[i + jj]; }
            const int n = (s0 + i + 1 < win) ? (s0 + i + 1) : win; const float inv = rcpf_((float)n);
            *(LAS unsigned*)(lds + ((8 * tg + i) * hg::LDK + 2 * cp) * 2) = pk2(a0 * inv - u0[i + win - 1], a1 * inv - u1[i + win - 1]); }
        LDS_SYNC();
        f32x4 acc[4];
#pragma unroll
        for (int ti = 0; ti < 4; ++ti) acc[ti] = (f32x4){0.f, 0.f, 0.f, 0.f};
#pragma unroll
        for (int ks = 0; ks < 4; ++ks) { const bf16x8 a = *(const bf16x8*)(POOLT + (size_t)g * 16384 + (16 * w + fr) * 128 + 32 * ks + 8 * q);
#pragma unroll
            for (int ti = 0; ti < 4; ++ti) { const bf16x8 bq = *(const LAS bf16x8*)(lds + ((16 * ti + fr) * hg::LDK + 32 * ks + 8 * q) * 2); acc[ti] = __builtin_amdgcn_mfma_f32_16x16x32_bf16(a, bq, acc[ti], 0, 0, 0); } }
        const f32x4 sc = *(const f32x4*)(p.pool_scale + g * 128 + 16 * w + 4 * q);
#pragma unroll
        for (int ti = 0; ti < 4; ++ti) { v2u wv; wv.x = pk2(acc[ti][0] * sc[0], acc[ti][1] * sc[1]); wv.y = pk2(acc[ti][2] * sc[2], acc[ti][3] * sc[3]);
            *(v2u*)(MIX + (size_t)(tok0 + 16 * ti + fr) * D + HW + g * 128 + 16 * w + 4 * q) = wv; }
        LDS_SYNC();
    }
}
}
__device__ __forceinline__ int hgrn_unit_of(int u, int G) { if (G != 256) return u; const int x = u & 7, jj = u >> 3; return ((2 * x + (jj >> 4)) << 4) | (jj & 15); }
__device__ __forceinline__ void phase_mixA(const Params& p, Frame& F) {
    for (int u = F.bid; u < 256; u += F.G) hg::hgrn_unit<false>(p, F, hgrn_unit_of(u, F.G), nullptr);
    for (int u = F.bid; u < NTOK / 64; u += F.G) hg::pool_unit(p, F, u);
}
__device__ __forceinline__ void phase_mixB(const Params& p, Frame& F) {
    for (int u = F.bid; u < 256; u += F.G) hg::hgrn_unit<true>(p, F, hgrn_unit_of(u, F.G), nullptr);
}

namespace rt {
constexpr int LG_STRIDE = 33;
constexpr int OFF_LG = 0, OFF_SQ = OFF_LG + 128 * LG_STRIDE * 4, OFF_TE = OFF_SQ + 512, OFF_TG = OFF_TE + 2048, OFF_CNT = OFF_TG + 2048, OFF_BASE = OFF_CNT + 128, OFF_END = OFF_BASE + 128;
__device__ __forceinline__ void split8(const f32x4 a, const f32x4 b, bf16x8& hi, bf16x8& lo) {
    const float v[8] = {a[0], a[1], a[2], a[3], b[0], b[1], b[2], b[3]};
    unsigned h[4], l[4];
#pragma unroll
    for (int j = 0; j < 4; ++j) { h[j] = pk2(v[2 * j], v[2 * j + 1]); l[j] = pk2(v[2 * j] - __uint_as_float(h[j] << 16), v[2 * j + 1] - __uint_as_float(h[j] & 0xffff0000u)); }
    hi = __builtin_bit_cast(bf16x8, (v4u){h[0], h[1], h[2], h[3]}); lo = __builtin_bit_cast(bf16x8, (v4u){l[0], l[1], l[2], l[3]});
}
}
__device__ __forceinline__ void phase_route(const Params& p, Frame& F) {
    LAS unsigned char* lds = F.lds;
    unsigned char* H8 = p.ws + WS_H8; unsigned* ctl = (unsigned*)(p.ws + WS_CTL); const bf16* X1B = (const bf16*)(p.ws + WS_X1B);
    int* LIST = (int*)(p.ws + WS_LIST); int* TOKES = (int*)(p.ws + WS_TOKES); float* TOKG = (float*)(p.ws + WS_TOKGATE);
    const bf16* WRH = (const bf16*)(p.ws + WS_WRH); const bf16* WRL = (const bf16*)(p.ws + WS_WRL); float* RS = (float*)(p.ws + WS_RS);
    const int lane = F.lane, w = F.wave, fr = lane & 15, q = lane >> 4, tid = F.tid;
    f32x4 g2a[4], g2b[4];
#pragma unroll
    for (int ks = 0; ks < 4; ++ks) { g2a[ks] = *(const f32x4*)(p.norm2_g + 128 * w + 32 * ks + 8 * q); g2b[ks] = *(const f32x4*)(p.norm2_g + 128 * w + 32 * ks + 8 * q + 4); }
    LAS unsigned char* hs = lds + 32768 + w * 2304;
    bf16x8 wh[2][4], wl[2][4];
#pragma unroll
    for (int nt = 0; nt < 2; ++nt)
#pragma unroll
        for (int ks = 0; ks < 4; ++ks) { const size_t o = (size_t)(16 * nt + fr) * D + 128 * w + 32 * ks + 8 * q; wh[nt][ks] = *(const bf16x8*)(WRH + o); wl[nt][ks] = *(const bf16x8*)(WRL + o); }
    LAS float* LG = (LAS float*)(lds + rt::OFF_LG); LAS float* SQ = (LAS float*)(lds + rt::OFF_SQ); LAS int* TE = (LAS int*)(lds + rt::OFF_TE); LAS float* TG = (LAS float*)(lds + rt::OFF_TG);
    LAS int* CNT = (LAS int*)(lds + rt::OFF_CNT); LAS int* BASE = (LAS int*)(lds + rt::OFF_BASE);
    const int nround = (NTOK / 128 + F.G - 1) / F.G;
    for (int it = 0; it < nround; ++it) {
        const int blk = it * F.G + F.bid; const bool active = blk < NTOK / 128; const int tok0 = blk * 128;
        __syncthreads();
        for (int i = tid; i < 128 * rt::LG_STRIDE + 128; i += NTHREADS) LG[i] = 0.f;
        if (tid < 32) CNT[tid] = 0;
        __syncthreads();
        if (active) {
            v4u xa[4];
            { const bf16* xr = X1B + (size_t)(tok0 + 16 * w + fr) * D + 128 * w + 8 * q;
#pragma unroll
              for (int ks = 0; ks < 4; ++ks) xa[ks] = *(const v4u*)(xr + 32 * ks); }
#pragma unroll 1
            for (int ii = 0; ii < 8; ++ii) {
                const int i = (ii + w) & 7;
                v4u ca[4];
#pragma unroll
                for (int ks = 0; ks < 4; ++ks) ca[ks] = xa[ks];
                if (ii < 7) { const bf16* xr = X1B + (size_t)(tok0 + 16 * ((i + 1) & 7) + fr) * D + 128 * w + 8 * q;
#pragma unroll
                    for (int ks = 0; ks < 4; ++ks) xa[ks] = *(const v4u*)(xr + 32 * ks); }
                f32x4 acc0 = {0.f, 0.f, 0.f, 0.f}, acc1 = {0.f, 0.f, 0.f, 0.f}; float sq = 0.f;
#pragma unroll
                for (int ks = 0; ks < 4; ++ks) { const v4u xw = ca[ks];
                    const f32x4 a = {__uint_as_float(xw.x << 16), __uint_as_float(xw.x & 0xffff0000u), __uint_as_float(xw.y << 16), __uint_as_float(xw.y & 0xffff0000u)};
                    const f32x4 b = {__uint_as_float(xw.z << 16), __uint_as_float(xw.z & 0xffff0000u), __uint_as_float(xw.w << 16), __uint_as_float(xw.w & 0xffff0000u)};
                    sq += (a[0] * a[0] + a[1] * a[1]) + (a[2] * a[2] + a[3] * a[3]) + (b[0] * b[0] + b[1] * b[1]) + (b[2] * b[2] + b[3] * b[3]);
                    { const f32x4 ya = a * g2a[ks], yb = b * g2b[ks]; v2u hw; hw.x = pk4_fp8(ya[0], ya[1], ya[2], ya[3]); hw.y = pk4_fp8(yb[0], yb[1], yb[2], yb[3]);
                      *(LAS v2u*)(hs + fr * 144 + 32 * ks + 8 * q) = hw; }
                    const bf16x8 xh = __builtin_bit_cast(bf16x8, xw);
                    acc0 = __builtin_amdgcn_mfma_f32_16x16x32_bf16(xh, wh[0][ks], acc0, 0, 0, 0); acc0 = __builtin_amdgcn_mfma_f32_16x16x32_bf16(xh, wl[0][ks], acc0, 0, 0, 0);
                    acc1 = __builtin_amdgcn_mfma_f32_16x16x32_bf16(xh, wh[1][ks], acc1, 0, 0, 0); acc1 = __builtin_amdgcn_mfma_f32_16x16x32_bf16(xh, wl[1][ks], acc1, 0, 0, 0); }
                asm volatile("s_waitcnt lgkmcnt(0)" ::: "memory");
#pragma unroll
                for (int hh = 0; hh < 2; ++hh) { const int row = (lane >> 3) + 8 * hh, c16 = lane & 7; const v4u hv = *(const LAS v4u*)(hs + row * 144 + 16 * c16);
                    *(v4u*)(H8 + (size_t)(tok0 + 16 * i + row) * D + 128 * w + 16 * c16) = hv; }
                asm volatile("s_waitcnt lgkmcnt(0)" ::: "memory");
                sq += __shfl_xor(sq, 16); sq += __shfl_xor(sq, 32);
                if (q == 0) __hip_atomic_fetch_add(SQ + 16 * i + fr, sq, __ATOMIC_RELAXED, __HIP_MEMORY_SCOPE_WORKGROUP);
#pragma unroll
                for (int r = 0; r < 4; ++r) { __hip_atomic_fetch_add(LG + (16 * i + 4 * q + r) * rt::LG_STRIDE + fr, acc0[r], __ATOMIC_RELAXED, __HIP_MEMORY_SCOPE_WORKGROUP); __hip_atomic_fetch_add(LG + (16 * i + 4 * q + r) * rt::LG_STRIDE + 16 + fr, acc1[r], __ATOMIC_RELAXED, __HIP_MEMORY_SCOPE_WORKGROUP); }
            }
        }
        __syncthreads();
        if (active && tid < 128) {
            const float rstd = rsqf_(SQ[tid] * (1.0f / D) + EPS); SQ[tid] = rstd;
            float v[32];
#pragma unroll
            for (int e = 0; e < 32; ++e) v[e] = LG[tid * rt::LG_STRIDE + e] * rstd + p.router_b[e];
            float tv[4]; int te[4];
#pragma unroll
            for (int r = 0; r < 4; ++r) { float bv = -INFINITY; int bi = 0;
#pragma unroll
                for (int e = 0; e < 32; ++e) { if (v[e] > bv) { bv = v[e]; bi = e; } }
                tv[r] = bv; te[r] = bi;
#pragma unroll
                for (int e = 0; e < 32; ++e) if (e == bi) v[e] = -INFINITY; }
            const float e1 = __expf(tv[1] - tv[0]), e2 = __expf(tv[2] - tv[0]), e3 = __expf(tv[3] - tv[0]); const float inv = 1.0f / (1.0f + e1 + e2 + e3);
            TE[tid * 4 + 0] = te[0]; TE[tid * 4 + 1] = te[1]; TE[tid * 4 + 2] = te[2]; TE[tid * 4 + 3] = te[3];
            TG[tid * 4 + 0] = inv; TG[tid * 4 + 1] = e1 * inv; TG[tid * 4 + 2] = e2 * inv; TG[tid * 4 + 3] = e3 * inv;
        }
        __syncthreads();
        int ee = 0, lrank = 0;
        if (active) { ee = TE[tid]; lrank = __hip_atomic_fetch_add(CNT + ee, 1, __ATOMIC_RELAXED, __HIP_MEMORY_SCOPE_WORKGROUP); }
        __syncthreads();
        if (active && tid < 32) { const int c = CNT[tid]; BASE[tid] = c ? (int)atomicAdd(ctl + CW_CNT + 64 * tid, (unsigned)c) : 0; }
        __syncthreads();
        if (active) { const int tok = tok0 + (tid >> 2), slot = BASE[ee] + lrank;
            LIST[ee * NTOK + slot] = tok; TOKES[tok * 4 + (tid & 3)] = (ee << 16) | slot; TOKG[tok * 4 + (tid & 3)] = TG[tid]; RS[ee * NTOK + slot] = SQ[tid >> 2]; }
    }
}

constexpr int N_PHASES = 9;
constexpr unsigned DUP_MASK = 0x000u;
__global__ void __launch_bounds__(NTHREADS, 2) fwd(Params p) {
    extern __shared__ __attribute__((aligned(16))) unsigned char lds[];
    Frame F; F.lds = (LAS unsigned char*)lds; F.tid = threadIdx.x; F.lane = F.tid & 63; F.wave = __builtin_amdgcn_readfirstlane(F.tid >> 6);
    F.G = gridDim.x; F.bid = blockIdx.x; F.gw = F.bid * NWAVES + F.wave; F.NGW = F.G * NWAVES;
    volatile LAS unsigned* MISC = (volatile LAS unsigned*)(F.lds + LDS_BYTES - 64);
    if (F.tid < 16) MISC[F.tid] = 0u;
    __syncthreads();
    const int lo = p.ph_lo, hi = p.ph_hi;
    XcdBarrier bar; bar.bar = (unsigned*)(p.ws + WS_CTL) + CW_BAR; bar.x = 0; bar.st = nullptr;
    if (hi - lo > 1) bar = xcd_barrier_post((unsigned*)(p.ws + WS_CTL) + CW_BAR, MISC + 8);
#define IN(k) (lo <= (k) && (k) < hi)
#define SEAM(k) do { if (IN(k) && IN((k) + 1)) xcd_barrier(bar); } while (0)
#define RUN(k, call) do { if (IN(k)) { call; if ((DUP_MASK >> (k)) & 1u) { __syncthreads(); call; } } } while (0)
    RUN(0, phase_prep(p, F)); SEAM(0);
    RUN(1, phase_inproj(p, F)); SEAM(1);
    RUN(2, phase_mixA(p, F)); SEAM(2);
    RUN(3, phase_mixB(p, F)); SEAM(3);
    RUN(4, phase_outproj(p, F)); SEAM(4);
    RUN(5, phase_route(p, F)); SEAM(5);
    RUN(6, phase_gateup(p, F)); SEAM(6);
    RUN(7, phase_down(p, F)); SEAM(7);
    RUN(8, phase_final(p, F));
#undef RUN
#undef IN
#undef SEAM
}

extern "C" void kernel_launch(void* const* d_in, const int* in_sizes, int n_in, void* d_out, int out_size, void* d_ws, size_t ws_size, hipStream_t stream) {
    static int grid = 0;
    if (grid == 0) {
        if (n_in != 18 || in_sizes[0] != NTOK * D || out_size != NTOK * D || ws_size < WS_END) {
            fprintf(stderr, "kernel_launch: unexpected shapes / workspace (n_in %d, in0 %d, out %d, ws %zu, need %zu); nothing launched\n", n_in, n_in > 0 ? in_sizes[0] : -1, out_size, ws_size, (size_t)WS_END);
            grid = -1; return; }
        int dev = 0, cus = 0;
        if (hipGetDevice(&dev) != hipSuccess || hipDeviceGetAttribute(&cus, hipDeviceAttributeMultiprocessorCount, dev) != hipSuccess) { grid = -1; return; }
        if (hipFuncSetAttribute((const void*)fwd, hipFuncAttributeMaxDynamicSharedMemorySize, LDS_BYTES) != hipSuccess) { fprintf(stderr, "kernel_launch: hipFuncSetAttribute failed\n"); grid = -1; return; }
        int per_cu = 0;
        if (hipOccupancyMaxActiveBlocksPerMultiprocessor(&per_cu, (const void*)fwd, NTHREADS, LDS_BYTES) != hipSuccess || per_cu < 1) fprintf(stderr, "kernel_launch: occupancy query says %d\n", per_cu);
        (void)hipGetLastError();
        grid = cus;
    }
    if (grid < 0) return;
    (void)hipMemsetAsync((char*)d_ws + WS_CTL, 0, CTL_ZERO_BYTES, stream);
    Params p{};
    p.x = (const float*)d_in[0]; p.norm1_g = (const float*)d_in[1]; p.w_in = (const float*)d_in[2]; p.hgrn_lb = (const float*)d_in[3]; p.hgrn_norm_g = (const float*)d_in[4];
    p.pool_w = (const float*)d_in[5]; p.pool_scale = (const float*)d_in[6]; p.w_out = (const float*)d_in[7]; p.norm2_g = (const float*)d_in[8]; p.router_w = (const float*)d_in[9];
    p.router_b = (const float*)d_in[10]; p.w_gate = (const float*)d_in[11]; p.b_gate = (const float*)d_in[12]; p.w_up = (const float*)d_in[13]; p.b_up = (const float*)d_in[14];
    p.w_down = (const float*)d_in[15]; p.b_down = (const float*)d_in[16]; p.norm_f_g = (const float*)d_in[17];
    p.out = (float*)d_out; p.ws = (unsigned char*)d_ws;
#if MK_PER_PHASE
    for (int k = 0; k < N_PHASES; ++k) { p.ph_lo = k; p.ph_hi = k + 1; hipLaunchKernelGGL(fwd, dim3(grid), dim3(NTHREADS), LDS_BYTES, stream, p); }
#else
    p.ph_lo = 0; p.ph_hi = N_PHASES; hipLaunchKernelGGL(fwd, dim3(grid), dim3(NTHREADS), LDS_BYTES, stream, p);
#endif
}
```

```cpp
#include <hip/hip_runtime.h>
#include <cstdio>
#include <cstdint>

#define LAS __attribute__((address_space(3)))
#define GAS __attribute__((address_space(1)))
typedef unsigned short bf16;
typedef short bf16x8 __attribute__((ext_vector_type(8)));
typedef float f32x4 __attribute__((ext_vector_type(4)));
typedef unsigned v4u __attribute__((ext_vector_type(4)));
typedef unsigned v2u __attribute__((ext_vector_type(2)));

#ifndef MK_PER_PHASE
#define MK_PER_PHASE 0
#endif

constexpr int NB = 4, SEQ = 8192, D = 1024, NTOK = NB * SEQ, INC = 2560, HW = 512, NH = 4, HD = 128;
constexpr int NE = 32, TOPK = 4, NROWS = NTOK * TOPK, FF = 1024;
constexpr float EPS = 1e-6f;
constexpr int NTHREADS = 512, NWAVES = 8;
constexpr int LDS_BYTES = 163840;
constexpr int LDS_TAB = 131072, LDS_OB = 134144, OB_PITCH = 144, LDS_BIAS = 153600, LDS_RS = 161792;

constexpr size_t KiB = 1024, MiB = 1024 * 1024;
constexpr size_t WS_CTL = 0, CTL_ZERO_BYTES = 64 * KiB;
constexpr size_t WS_POOLT = 512 * KiB;
constexpr size_t WS_WRH = 768 * KiB, WS_WRL = 832 * KiB;
constexpr size_t WS_WINT = 1 * MiB;
constexpr size_t WS_LIST = 1 * MiB;
constexpr size_t WS_TOKES = 5 * MiB;
constexpr size_t WS_TOKGATE = 5 * MiB + 512 * KiB;
constexpr size_t WS_WOUTT = 6 * MiB;
constexpr size_t WS_WD8 = 8 * MiB;
constexpr size_t WS_WGU8 = 40 * MiB;
constexpr size_t WS_H8 = 104 * MiB;
constexpr size_t WS_ACT8 = 136 * MiB;
constexpr size_t WS_XN = WS_ACT8;
constexpr size_t WS_YS = 264 * MiB + 512 * KiB;
constexpr size_t WS_RS = WS_YS;
constexpr size_t WS_PROJ = WS_YS;
constexpr size_t WS_MIX = WS_XN + 64 * MiB;
constexpr size_t WS_RSTD1 = 640 * KiB;
constexpr size_t WS_X1B = WS_YS + 160 * MiB;
constexpr size_t WS_HST = WS_YS + 224 * MiB;
constexpr size_t WS_HDEC = WS_HST + 16 * MiB;
constexpr size_t WS_END = WS_YS + 256 * MiB + 512 * KiB;
constexpr float WSCALE = 64.0f, WINV = 1.0f / 64.0f;
constexpr int CW_CNT = 8192;
constexpr int CW_BAR = 0;

struct Params {
    const float *x, *norm1_g, *w_in, *hgrn_lb, *hgrn_norm_g, *pool_w, *pool_scale, *w_out, *norm2_g, *router_w, *router_b,
        *w_gate, *b_gate, *w_up, *b_up, *w_down, *b_down, *norm_f_g;
    float* out; unsigned char* ws; int ph_lo, ph_hi;
};

__device__ __forceinline__ unsigned f2bf(float f) { unsigned u = __float_as_uint(f); return (u + 0x7fffu + ((u >> 16) & 1u)) >> 16; }
__device__ __forceinline__ unsigned pk2(float lo, float hi) { unsigned r; asm("v_cvt_pk_bf16_f32 %0, %1, %2" : "=v"(r) : "v"(lo), "v"(hi)); return r; }
__device__ __forceinline__ float bf2f(unsigned b) { return __uint_as_float(b << 16); }
__device__ __forceinline__ float wave_sum(float v) {
#pragma unroll
    for (int o = 1; o < 64; o <<= 1) v += __shfl_xor(v, o);
    return v;
}
#define LDS_SYNC() do { asm volatile("s_waitcnt lgkmcnt(0)" ::: "memory"); __builtin_amdgcn_s_barrier(); asm volatile("" ::: "memory"); } while (0)
__device__ __forceinline__ float rcpf_(float x) { return __builtin_amdgcn_rcpf(x); }
__device__ __forceinline__ float rsqf_(float x) { return __builtin_amdgcn_rsqf(x); }
__device__ __forceinline__ float ex2f_(float x) { return __builtin_amdgcn_exp2f(x); }
__device__ __forceinline__ float lg2f_(float x) { return __builtin_amdgcn_logf(x); }
__device__ __forceinline__ float sigmoidf_(float z) { return rcpf_(1.0f + ex2f_(-1.4426950408889634f * z)); }
__device__ __forceinline__ unsigned pk4_fp8(float a, float b, float c, float d) { int w = __builtin_amdgcn_cvt_pk_fp8_f32(a, b, 0, false); w = __builtin_amdgcn_cvt_pk_fp8_f32(c, d, w, true); return (unsigned)w; }

#define XB_TMO      128
#define XB_XCNT(j)  (256  + 64 * (j))
#define XB_XSUB(j)  (1280 + 64 * (j))
#define XB_XGEN(j)  (2304 + 64 * (j))
#define XB_TOP      3328
#define XB_TOPGEN   3392
#define XCD_BAR_WORDS 3456
#define XB_SPIN_CAP (1u << 18)
__device__ __forceinline__ unsigned xb_ld(unsigned* p)              { return __hip_atomic_load(p, __ATOMIC_RELAXED, __HIP_MEMORY_SCOPE_AGENT); }
__device__ __forceinline__ unsigned xb_add(unsigned* p, unsigned v) { return __hip_atomic_fetch_add(p, v, __ATOMIC_RELAXED, __HIP_MEMORY_SCOPE_AGENT); }
__device__ __forceinline__ unsigned xb_xcc_id() { return (unsigned)__builtin_amdgcn_s_getreg((3 << 11) | 20) & 0xFu; }
#define XB_SPIN(cond, bar) do { unsigned _sp = 0; while (cond) { __builtin_amdgcn_s_sleep(1); \
    if ((++_sp & 255u) == 0u) { if (xb_ld(&(bar)[XB_TMO])) break; if (_sp > XB_SPIN_CAP) { atomicAdd(&(bar)[XB_TMO], 1u); break; } } } } while (0)
struct XcdBarrier { unsigned* bar; unsigned x; volatile LAS unsigned* st; };
__device__ __forceinline__ XcdBarrier xcd_barrier_post(unsigned* bar, volatile LAS unsigned* st) {
    XcdBarrier b; b.bar = bar; b.x = xb_xcc_id(); b.st = st;
    if (threadIdx.x == 0) (void)xb_add(&bar[XB_XCNT(b.x)], 1u);
    return b;
}
__device__ __forceinline__ void xcd_barrier_complete(unsigned* bar, unsigned x, unsigned& nloc, unsigned& nx) {
    const unsigned G = gridDim.x * gridDim.y * gridDim.z;
    unsigned sum, cnt, mine, sp = 0u;
    for (;;) {
        sum = 0u; cnt = 0u; mine = 0u;
#pragma unroll
        for (unsigned j = 0; j < 16; ++j) { const unsigned c = xb_ld(&bar[XB_XCNT(j)]); sum += c; cnt += (c > 0u) ? 1u : 0u; mine = (j == x) ? c : mine; }
        if (sum == G) break;
        __builtin_amdgcn_s_sleep(1);
        if ((++sp & 255u) == 0u) { if (xb_ld(&bar[XB_TMO])) break; if (sp > XB_SPIN_CAP) { atomicAdd(&bar[XB_TMO], 1u); break; } }
    }
    nloc = mine > 0u ? mine : 1u; nx = cnt > 0u ? cnt : 1u;
}
__device__ __forceinline__ void xcd_barrier(const XcdBarrier& b) {
    asm volatile("s_waitcnt vmcnt(0)" ::: "memory");
    __syncthreads();
    if (threadIdx.x == 0) {
        unsigned* bar = b.bar;
        __builtin_amdgcn_s_waitcnt(0);
        unsigned nloc = b.st[0], nx = b.st[1];
        if (nloc == 0u) { xcd_barrier_complete(bar, b.x, nloc, nx); b.st[0] = nloc; b.st[1] = nx; }
        const unsigned old = xb_add(&bar[XB_XSUB(b.x)], 1u);
        const unsigned gen = old / nloc;
        if (old + 1u == (gen + 1u) * nloc) {
            __builtin_amdgcn_fence(__ATOMIC_RELEASE, "agent");
            asm volatile("s_waitcnt vmcnt(0)" ::: "memory");
            const unsigned og = xb_add(&bar[XB_TOP], 1u);
            const unsigned tg = og / nx;
            if (og + 1u == (tg + 1u) * nx) xb_add(&bar[XB_TOPGEN], 1u);
            else XB_SPIN(xb_ld(&bar[XB_TOPGEN]) == tg, bar);
            __builtin_amdgcn_fence(__ATOMIC_ACQUIRE, "agent");
            xb_add(&bar[XB_XGEN(b.x)], 1u);
            asm volatile("s_waitcnt vmcnt(0)" ::: "memory");
        } else {
            XB_SPIN(xb_ld(&bar[XB_XGEN(b.x)]) == gen, bar);
            __builtin_amdgcn_fence(__ATOMIC_ACQUIRE, "agent");
            asm volatile("s_waitcnt vmcnt(0)" ::: "memory");
        }
    }
    __syncthreads();
}

struct Frame {
    LAS unsigned char* lds;
    int tid, lane, wave, G, bid, gw, NGW;
};

__device__ __forceinline__ void transpose_item(const float* W, int K, int N, bf16* WT, int ldt, int k0, int n0, int rowbase, LAS float* scr, int lane, const float* kscale = nullptr) {
#pragma unroll 32
    for (int i = 0; i < 32; ++i) { const int kk = 2 * i + (lane >> 5); scr[kk * 33 + (lane & 31)] = W[(size_t)(k0 + kk) * N + n0 + (lane & 31)] * (kscale ? kscale[k0 + kk] : 1.0f); }
    asm volatile("s_waitcnt lgkmcnt(0)" ::: "memory");
    const int c = lane & 7;
#pragma unroll
    for (int j = 0; j < 4; ++j) { const int n = (lane >> 3) + 8 * j; const LAS float* s = scr + (8 * c) * 33 + n;
        v4u o; o.x = pk2(s[0 * 33], s[1 * 33]); o.y = pk2(s[2 * 33], s[3 * 33]); o.z = pk2(s[4 * 33], s[5 * 33]); o.w = pk2(s[6 * 33], s[7 * 33]);
        *(v4u*)(WT + (size_t)(rowbase + n) * ldt + k0 + 8 * c) = o; }
    asm volatile("s_waitcnt lgkmcnt(0)" ::: "memory");
}

constexpr int CV_WGU = 2 * NE * 256, CV_WD = NE * 256, CV_WD_A = CV_WD / 2, CV_PITCH = 144, CV_LDS = 32 * CV_PITCH;
struct CvItem { const float* src; unsigned char* dst; };
__device__ __forceinline__ unsigned perm_b32(unsigned hi, unsigned lo, unsigned sel) { return __builtin_amdgcn_perm(hi, lo, sel); }
__device__ __forceinline__ CvItem cv_addr(const Params& p, int mat, int r, int lane) {
    const int e = r >> 8, kg = (r >> 5) & 7, ng = r & 31, k0 = 128 * kg, n0 = 32 * ng;
    const float* W = (mat == 0 ? p.w_gate : mat == 1 ? p.w_up : p.w_down) + (size_t)e * D * FF;
    CvItem c; c.src = W + (size_t)(k0 + 4 * (lane >> 3)) * FF + n0 + 4 * (lane & 7);
    if (mat == 2) c.dst = p.ws + WS_WD8 + ((size_t)e * D + n0) * FF + k0;
    else c.dst = p.ws + WS_WGU8 + ((size_t)e * 2048 + (n0 >> 7) * 256 + (mat == 1 ? 128 : 0) + (n0 & 127)) * D + k0;
    return c;
}
__device__ __forceinline__ void cv_load(const CvItem& c, f32x4 (&v)[16]) {
#pragma unroll
    for (int jj = 0; jj < 16; ++jj) v[jj] = *(const f32x4*)(c.src + (size_t)(32 * (jj >> 2) + (jj & 3)) * FF);
}
__device__ __forceinline__ void cv_store(const CvItem& c, const f32x4 (&v)[16], LAS unsigned char* scr, int lane) {
    const int g = lane >> 3, cq = lane & 7;
#pragma unroll
    for (int a = 0; a < 4; ++a) { unsigned d[4];
#pragma unroll
        for (int b = 0; b < 4; ++b) { const f32x4 x = v[4 * a + b] * WSCALE; d[b] = pk4_fp8(x[0], x[1], x[2], x[3]); }
        const unsigned x0 = perm_b32(d[1], d[0], 0x05010400u), x1 = perm_b32(d[1], d[0], 0x07030602u), y0 = perm_b32(d[3], d[2], 0x05010400u), y1 = perm_b32(d[3], d[2], 0x07030602u);
        LAS unsigned char* q = scr + (4 * cq) * CV_PITCH + 32 * a + 4 * g;
        *(LAS unsigned*)(q) = perm_b32(y0, x0, 0x05040100u); *(LAS unsigned*)(q + CV_PITCH) = perm_b32(y0, x0, 0x07060302u);
        *(LAS unsigned*)(q + 2 * CV_PITCH) = perm_b32(y1, x1, 0x05040100u); *(LAS unsigned*)(q + 3 * CV_PITCH) = perm_b32(y1, x1, 0x07060302u); }
    asm volatile("s_waitcnt lgkmcnt(0)" ::: "memory");
#pragma unroll
    for (int i = 0; i < 4; ++i) { const int row = (lane >> 3) + 8 * i, ch = lane & 7; const v4u w = *(const LAS v4u*)(scr + row * CV_PITCH + 16 * ch); *(v4u*)(c.dst + (size_t)row * D + 16 * ch) = w; }
    asm volatile("s_waitcnt lgkmcnt(0)" ::: "memory");
}
struct CvJob {
    int mat0, item, stride, limit; bool live; CvItem c; f32x4 v[16];
    __device__ __forceinline__ void init(int mat0_, int first, int stride_, int limit_) { mat0 = mat0_; item = first; stride = stride_; limit = limit_; live = false; }
    __device__ __forceinline__ void top(const Params& p, int lane) { live = item < limit; const int it = live ? item : 0;
        c = cv_addr(p, mat0 + it / (NE * 256), it % (NE * 256), lane); cv_load(c, v); }
    __device__ __forceinline__ void bottom(LAS unsigned char* scr, int lane) {
        if (live) {
#pragma unroll
            for (int jj = 0; jj < 16; ++jj) asm volatile("" : "+v"(v[jj]));
            cv_store(c, v, scr, lane); item += stride; live = false; }
    }
    __device__ __forceinline__ void rest(const Params& p, LAS unsigned char* scr, int lane) { run(p, scr, lane, 0x7fffffff / 2); }
    __device__ __forceinline__ void run(const Params& p, LAS unsigned char* scr, int lane, int n) {
        if (n > (limit - item + stride - 1) / stride) n = (limit - item + stride - 1) / stride;
        if (n <= 0) return;
        f32x4 vb[16]; CvItem c0 = addr_of(p, item, lane), c1;
        cv_load(c0, v);
        for (int k = 0; k < n; k += 2) {
            c1 = addr_of(p, item + ((k + 1 < n) ? stride : 0), lane); cv_load(c1, vb);
#pragma unroll
            for (int jj = 0; jj < 16; ++jj) asm volatile("" : "+v"(v[jj]));
            cv_store(c0, v, scr, lane); item += stride;
            if (k + 1 >= n) break;
            c0 = addr_of(p, item + ((k + 2 < n) ? stride : 0), lane); cv_load(c0, v);
#pragma unroll
            for (int jj = 0; jj < 16; ++jj) asm volatile("" : "+v"(vb[jj]));
            cv_store(c1, vb, scr, lane); item += stride;
        }
    }
    __device__ __forceinline__ CvItem addr_of(const Params& p, int it, int lane) const { return cv_addr(p, mat0 + it / (NE * 256), it % (NE * 256), lane); }
};

__device__ __forceinline__ void phase_prep(const Params& p, Frame& F) {
    LAS float* scr = (LAS float*)(F.lds + F.wave * 16896);
    bf16* WINT = (bf16*)(p.ws + WS_WINT); bf16* WOUTT = (bf16*)(p.ws + WS_WOUTT);
    bf16* POOLT = (bf16*)(p.ws + WS_POOLT); bf16* XN = (bf16*)(p.ws + WS_XN);
    constexpr int I_IN = (D / 64) * (INC / 32), I_OUT = (D / 64) * (D / 32), I_POOL = 4 * (128 / 64) * (128 / 32);
    constexpr int NITEMS = I_IN + I_OUT + I_POOL;
    for (int it = F.gw; it < NITEMS; it += F.NGW) {
        int r = it;
        if (r < I_IN) { const int nb = INC / 32; transpose_item(p.w_in, D, INC, WINT, D, 64 * (r / nb), 32 * (r % nb), 32 * (r % nb), scr, F.lane, p.norm1_g); continue; } r -= I_IN;
        if (r < I_OUT) { const int nb = D / 32; transpose_item(p.w_out, D, D, WOUTT, D, 64 * (r / nb), 32 * (r % nb), 32 * (r % nb), scr, F.lane); continue; } r -= I_OUT;
        { const int g = r / 8, q = r % 8; transpose_item(p.pool_w + (size_t)g * 128 * 128, 128, 128, POOLT + (size_t)g * 128 * 128, 128, 64 * (q / 4), 32 * (q % 4), 32 * (q % 4), scr, F.lane); }
    }
    { bf16* WRH = (bf16*)(p.ws + WS_WRH); bf16* WRL = (bf16*)(p.ws + WS_WRL);
      for (int i = F.bid * NTHREADS + F.tid; i < NE * D; i += F.G * NTHREADS) { const int e = i / D, k = i % D; const float wv = p.norm2_g[k] * p.router_w[k * NE + e]; const unsigned h = f2bf(wv); WRH[i] = (bf16)h; WRL[i] = (bf16)f2bf(wv - bf2f(h)); } }
    float* RSTD1 = (float*)(p.ws + WS_RSTD1);
    for (int m = 2 * F.gw; m < NTOK; m += 2 * F.NGW) {
        f32x4 v[2][4];
#pragma unroll
        for (int r = 0; r < 2; ++r)
#pragma unroll
            for (int j = 0; j < 4; ++j) v[r][j] = ((const f32x4*)(p.x + (size_t)(m + r) * D) + F.lane)[64 * j];
#pragma unroll
        for (int r = 0; r < 2; ++r) { float s = 0.f;
#pragma unroll
            for (int j = 0; j < 4; ++j) s += (v[r][j].x * v[r][j].x + v[r][j].y * v[r][j].y) + (v[r][j].z * v[r][j].z + v[r][j].w * v[r][j].w);
            const float rstd = rsqf_(wave_sum(s) * (1.0f / D) + EPS);
            if (F.lane == 0) RSTD1[m + r] = rstd;
            v2u* o8 = (v2u*)(XN + (size_t)(m + r) * D) + F.lane;
#pragma unroll
            for (int j = 0; j < 4; ++j) { v2u w; w.x = pk2(v[r][j].x, v[r][j].y); w.y = pk2(v[r][j].z, v[r][j].w); o8[64 * j] = w; } }
    }
}

__device__ __forceinline__ void load_tables(const Params& p, Frame& F, LAS int* sb);
typedef float hg2 __attribute__((ext_vector_type(2)));
__device__ __forceinline__ void phase_final(const Params& p, Frame& F) {
    const unsigned char* YS = p.ws + WS_YS; const bf16* X1B = (const bf16*)(p.ws + WS_X1B);
    const int* TOKES = (const int*)(p.ws + WS_TOKES); const float* TOKG = (const float*)(p.ws + WS_TOKGATE);
    LAS int* sb = (LAS int*)(F.lds + LDS_TAB); if (p.ph_lo > 6) load_tables(p, F, sb);
    const f32x4* gr = (const f32x4*)p.norm_f_g + F.lane;
    for (int m0 = 4 * F.gw; m0 < NTOK; m0 += 4 * F.NGW) {
        f32x4 v[4][4]; int es[4][4]; float gt[4][4];
#pragma unroll
        for (int r = 0; r < 4; ++r) {
#pragma unroll
            for (int k = 0; k < 4; ++k) { es[r][k] = TOKES[(m0 + r) * 4 + k]; gt[r][k] = TOKG[(m0 + r) * 4 + k]; }
#pragma unroll
            for (int j = 0; j < 4; ++j) { const v2u xw = ((const v2u*)(X1B + (size_t)(m0 + r) * D) + F.lane)[64 * j];
                v[r][j] = (f32x4){__uint_as_float(xw.x << 16), __uint_as_float(xw.x & 0xffff0000u), __uint_as_float(xw.y << 16), __uint_as_float(xw.y & 0xffff0000u)}; } }
#pragma unroll
        for (int r = 0; r < 4; ++r)
#pragma unroll
            for (int k = 0; k < 4; ++k) { const int row = sb[es[r][k] >> 16] + (es[r][k] & 0xffff); const float g = gt[r][k];
                const unsigned* s4 = (const unsigned*)(YS + (size_t)row * D) + F.lane;
                unsigned w[4];
#pragma unroll
                for (int j = 0; j < 4; ++j) w[j] = s4[64 * j];
#pragma unroll
                for (int j = 0; j < 4; ++j) { const hg2 lo = __builtin_amdgcn_cvt_pk_f32_fp8((int)w[j], false), hi = __builtin_amdgcn_cvt_pk_f32_fp8((int)w[j], true);
                    v[r][j].x += g * lo.x; v[r][j].y += g * lo.y; v[r][j].z += g * hi.x; v[r][j].w += g * hi.y; } }
#pragma unroll
        for (int r = 0; r < 4; ++r) { float s = 0.f;
#pragma unroll
            for (int j = 0; j < 4; ++j) s += (v[r][j].x * v[r][j].x + v[r][j].y * v[r][j].y) + (v[r][j].z * v[r][j].z + v[r][j].w * v[r][j].w);
            const float rstd = rsqf_(wave_sum(s) * (1.0f / D) + EPS);
            f32x4* xr = (f32x4*)(p.out + (size_t)(m0 + r) * D) + F.lane;
#pragma unroll
            for (int j = 0; j < 4; ++j) { const f32x4 g = gr[64 * j]; f32x4 o; o.x = v[r][j].x * rstd * g.x; o.y = v[r][j].y * rstd * g.y; o.z = v[r][j].z * rstd * g.z; o.w = v[r][j].w * rstd * g.w; xr[64 * j] = o; } }
    }
}

namespace gg {
constexpr int BM = 256, BK = 64, HALF = 128, HTB = HALF * BK * 2, STAGE_BYTES = 8 * HTB, NXCD = 8, WGM = 8;
typedef int i32x4 __attribute__((ext_vector_type(4)));
typedef int i32x8 __attribute__((ext_vector_type(8)));
__device__ __forceinline__ int lds_byte(int r, int c) { const int st = (r >> 4) * 2 + (c >> 5), rr = r & 15, cc = c & 31, ob = rr * 64 + cc * 2; return st * 1024 + (ob ^ (((ob >> 9) & 1) << 5)); }
__device__ __forceinline__ void stage_rc(int b, int& R, int& C) { const int st = b / 1024, sb = b % 1024, swz = sb ^ (((sb >> 9) & 1) << 5); R = (st >> 1) * 16 + swz / 64; C = (st & 1) * 32 + (swz % 64) / 2; }
__device__ __forceinline__ int perm32(int rho) { const int n = rho >> 4, i = rho & 15; return 8 * (i >> 2) + 4 * n + (i & 3); }
__device__ __forceinline__ unsigned cvt_pk_bf16(float lo, float hi) { unsigned r; asm volatile("v_cvt_pk_bf16_f32 %0, %1, %2" : "=v"(r) : "v"(lo), "v"(hi)); return r; }

struct Unit { const char* B; unsigned char* dst; int row0, nvalid, pn, e, r0, cnt; };

template <class Sched, class Epi>
__device__ __forceinline__ void gemm_phase(LAS unsigned char* lds, const Sched& S, const Epi& E) {
    const int tid = threadIdx.x, wid = __builtin_amdgcn_readfirstlane(tid >> 6), lane = tid & 63, wr = wid >> 2, wc = wid & 3, fr = lane & 15, fq = lane >> 4;
    constexpr int KB = Sched::KB, nt = KB / 128; constexpr bool F8 = Sched::F8;
    int R[2], C[2]; unsigned voffB[2];
#pragma unroll
    for (int i = 0; i < 2; ++i) { stage_rc(tid * 16 + i * 8192, R[i], C[i]); const int Rb = Epi::PERM ? ((R[i] & ~31) + perm32(R[i] & 31)) : R[i]; voffB[i] = (unsigned)(Rb * KB + C[i] * 2); }
    const size_t kstep = (size_t)(BK * 2);
    const size_t hstep = (size_t)HALF * KB;
    const unsigned ldsw = (unsigned)wid * 1024u;
    const int aoff = lds_byte(wr * 64 + fr, fq * 8), boff = lds_byte(wc * 32 + fr, fq * 8);
    const char* const Abase = S.abase();
#define PG8_SA(b, h) (((b) * 2 + (h)) * HTB)
#define PG8_SB(b, h) ((4 + (b) * 2 + (h)) * HTB)
#define PG8_STAGE(bufoff, gbase, voff) do { _Pragma("unroll") for (int _i = 0; _i < 2; ++_i) \
        __builtin_amdgcn_global_load_lds((const unsigned*)((const char*)(gbase) + (voff)[_i]), (LAS unsigned*)(lds + (bufoff) + ldsw + _i * 8192), 16, 0, 0); } while (0)
#define PG8_RD(off) (*(const LAS i32x4*)(lds + (off)))
#define PG8_LDA(dst, b, h) do { _Pragma("unroll") for (int m = 0; m < 4; ++m) { if constexpr (F8) dst##8[m] = __builtin_shufflevector(PG8_RD(PG8_SA(b, h) + aoff + m * 2048), PG8_RD(PG8_SA(b, h) + aoff + m * 2048 + 1024), 0, 1, 2, 3, 4, 5, 6, 7); \
        else { _Pragma("unroll") for (int k = 0; k < 2; ++k) dst[m][k] = *(const LAS bf16x8*)(lds + PG8_SA(b, h) + aoff + m * 2048 + k * 1024); } } } while (0)
#define PG8_LDB(dst, b, h) do { _Pragma("unroll") for (int n = 0; n < 2; ++n) { if constexpr (F8) dst##8[n] = __builtin_shufflevector(PG8_RD(PG8_SB(b, h) + boff + n * 2048), PG8_RD(PG8_SB(b, h) + boff + n * 2048 + 1024), 0, 1, 2, 3, 4, 5, 6, 7); \
        else { _Pragma("unroll") for (int k = 0; k < 2; ++k) dst[n][k] = *(const LAS bf16x8*)(lds + PG8_SB(b, h) + boff + n * 2048 + k * 1024); } } } while (0)
#define PG8_MMA(ai, bj, At, Bt) do { __builtin_amdgcn_s_setprio(1); _Pragma("unroll") for (int m = 0; m < 4; ++m) _Pragma("unroll") for (int n = 0; n < 2; ++n) { \
        if constexpr (F8) asm volatile("v_mfma_scale_f32_16x16x128_f8f6f4 %0, %1, %2, %0, %3, %3 op_sel_hi:[0,0,0]" : "+v"(acc[ai][bj][m][n]) : "v"(Bt##8[n]), "v"(At##8[m]), "v"(sc1)); \
        else { _Pragma("unroll") for (int k = 0; k < 2; ++k) acc[ai][bj][m][n] = __builtin_amdgcn_mfma_f32_16x16x32_bf16(Bt[n][k], At[m][k], acc[ai][bj][m][n], 0, 0, 0); } } \
        __builtin_amdgcn_s_setprio(0); } while (0)
#define PG8_WAIT_V(n) asm volatile("s_waitcnt vmcnt(" #n ")" ::: "memory")
#define PG8_WAIT_L(n) asm volatile("s_waitcnt lgkmcnt(" #n ")" ::: "memory")
#define PG8_BAR __builtin_amdgcn_s_barrier()
#define PG8_SCHED __builtin_amdgcn_sched_barrier(0)
    Unit cur, nxt; int ui = 0;
    if (!S.next(0, cur)) return;
    bool has_next = S.next(1, nxt);
    unsigned ao[2][2], nao[2][2];
    { int t0[2][2] = {{0, 0}, {0, 0}}, t1[2][2] = {{0, 0}, {0, 0}}; S.aload(cur, R, C, t0); if (has_next) S.aload(nxt, R, C, t1); S.afin(cur, R, C, t0, ao);
      if (has_next) S.afin(nxt, R, C, t1, nao); else { nao[0][0] = ao[0][0]; nao[0][1] = ao[0][1]; nao[1][0] = ao[1][0]; nao[1][1] = ao[1][1]; } }
    asm volatile("" : "+v"(ao[0][0]), "+v"(ao[0][1]), "+v"(ao[1][0]), "+v"(ao[1][1]));
    asm volatile("" : "+v"(nao[0][0]), "+v"(nao[0][1]), "+v"(nao[1][0]), "+v"(nao[1][1]));
    f32x4 acc[2][2][4][2];
#pragma unroll
    for (int a = 0; a < 2; ++a)
#pragma unroll
        for (int b = 0; b < 2; ++b)
#pragma unroll
            for (int m = 0; m < 4; ++m)
#pragma unroll
                for (int n = 0; n < 2; ++n) acc[a][b][m][n] = (f32x4){0.f, 0.f, 0.f, 0.f};
    bf16x8 At[4][2], B0[2][2], B1[2][2]; i32x8 At8[4], B08[2], B18[2];
    int sc1 = 0x7F7F7F7F; asm volatile("" : "+v"(sc1));
    const char* cB = cur.B;
    PG8_STAGE(PG8_SB(0, 0), cB, voffB); PG8_STAGE(PG8_SB(0, 1), cB + hstep, voffB); PG8_STAGE(PG8_SA(0, 0), Abase, ao[0]); PG8_STAGE(PG8_SA(0, 1), Abase, ao[1]);
    if (wr == 1) PG8_BAR;
    PG8_WAIT_V(2); PG8_BAR;
    PG8_STAGE(PG8_SB(1, 0), cB + kstep, voffB); PG8_STAGE(PG8_SA(1, 0), Abase + kstep, ao[0]); PG8_STAGE(PG8_SB(1, 1), cB + hstep + kstep, voffB);
    PG8_WAIT_V(6); PG8_BAR;
    for (;;) {
        const char* nB = has_next ? nxt.B : cB;
        if constexpr (Epi::BIAS_LDS) {
            const float* bsrc = E.bias_src(cur, lane);
            __builtin_amdgcn_global_load_lds((const unsigned*)bsrc, (LAS unsigned*)(lds + LDS_BIAS + wid * 1024), 16, 0, 0);
        }
        if constexpr (Epi::RS_LDS) { if (wid == 0) __builtin_amdgcn_global_load_lds((const unsigned*)E.rs_src(cur, lane), (LAS unsigned*)(lds + LDS_RS), 16, 0, 0); }
#pragma unroll 1
        for (int t = 0; t < nt; t += 2) {
            const bool last = (t == nt - 2);
            const char* a1 = Abase + (size_t)(t + 1) * kstep;
            const char* a2 = last ? Abase : Abase + (size_t)(t + 2) * kstep; const char* b2 = last ? nB : cB + (size_t)(t + 2) * kstep;
            const char* a3 = a2 + kstep; const char* b3 = b2 + kstep;
            unsigned s2[2][2];
#pragma unroll
            for (int h = 0; h < 2; ++h)
#pragma unroll
                for (int i = 0; i < 2; ++i) s2[h][i] = last ? nao[h][i] : ao[h][i];
            PG8_LDB(B0, 0, 0); PG8_LDB(B1, 0, 1); PG8_SCHED; PG8_LDA(At, 0, 0); PG8_STAGE(PG8_SA(1, 1), a1, ao[1]);
            PG8_WAIT_V(8); PG8_WAIT_L(0); PG8_BAR; PG8_MMA(0, 0, At, B0); PG8_MMA(0, 1, At, B1); PG8_BAR; PG8_SCHED;
            PG8_LDA(At, 0, 1); PG8_STAGE(PG8_SB(0, 0), b2, voffB); PG8_STAGE(PG8_SB(0, 1), b2 + hstep, voffB); PG8_STAGE(PG8_SA(0, 0), a2, s2[0]);
            PG8_WAIT_V(8); PG8_WAIT_L(0); PG8_BAR; PG8_MMA(1, 0, At, B0); PG8_MMA(1, 1, At, B1); PG8_BAR; PG8_SCHED;
            PG8_LDB(B0, 1, 0); PG8_LDB(B1, 1, 1); PG8_SCHED; PG8_LDA(At, 1, 0); PG8_STAGE(PG8_SA(0, 1), a2, s2[1]);
            PG8_WAIT_V(8); PG8_WAIT_L(0); PG8_BAR; PG8_MMA(0, 0, At, B0); PG8_MMA(0, 1, At, B1); PG8_BAR; PG8_SCHED;
            PG8_LDA(At, 1, 1); PG8_STAGE(PG8_SB(1, 0), b3, voffB); PG8_STAGE(PG8_SB(1, 1), b3 + hstep, voffB); PG8_STAGE(PG8_SA(1, 0), a3, s2[0]);
            PG8_WAIT_V(8); PG8_WAIT_L(0); PG8_BAR; PG8_MMA(1, 0, At, B0); PG8_MMA(1, 1, At, B1); PG8_BAR; PG8_SCHED;
        }
        if (wr == 0) PG8_BAR;
        Unit nn; bool hn2 = false; int tk[2][2] = {{0, 0}, {0, 0}};
        if (has_next) { hn2 = S.next(ui + 2, nn); if (hn2) S.aload(nn, R, C, tk); }
        asm volatile("" ::: "memory");
        if constexpr (F8) asm volatile("s_nop 15\n\ts_nop 15" ::: "memory");
        { int fr_e = fr, fq_e = fq; asm volatile("" : "+v"(fr_e), "+v"(fq_e)); E(acc, cur, wr, wc, fr_e, fq_e); }
        if (!has_next) break;
#pragma unroll
        for (int a = 0; a < 2; ++a)
#pragma unroll
            for (int b = 0; b < 2; ++b)
#pragma unroll
                for (int m = 0; m < 4; ++m)
#pragma unroll
                    for (int n = 0; n < 2; ++n) acc[a][b][m][n] = (f32x4){0.f, 0.f, 0.f, 0.f};
        cur = nxt; cB = nB; ++ui;
#pragma unroll
        for (int h = 0; h < 2; ++h)
#pragma unroll
            for (int i = 0; i < 2; ++i) ao[h][i] = nao[h][i];
        has_next = hn2;
        if (has_next) { nxt = nn; S.afin(nxt, R, C, tk, nao); asm volatile("" : "+v"(nao[0][0]), "+v"(nao[0][1]), "+v"(nao[1][0]), "+v"(nao[1][1])); }
        if (wr == 1) PG8_BAR;
    }
    PG8_WAIT_V(0);
    PG8_BAR;
#undef PG8_SA
#undef PG8_SB
#undef PG8_STAGE
#undef PG8_LDA
#undef PG8_RD
#undef PG8_LDB
#undef PG8_MMA
#undef PG8_WAIT_V
#undef PG8_WAIT_L
#undef PG8_BAR
#undef PG8_SCHED
}

struct DenseSched {
    static constexpr int KB = 2048; static constexpr bool F8 = false;
    const char* A; const char* Bt; int nM, nN, nwg, G, c;
    __device__ __forceinline__ void init(const void* A_, const void* Bt_, int M, int N, int G_, int c_) { A = (const char*)A_; Bt = (const char*)Bt_; nM = M / BM; nN = N / BM; nwg = nM * nN; G = G_; c = c_; }
    __device__ __forceinline__ const char* abase() const { return A; }
    __device__ __forceinline__ bool next(int i, Unit& u) const {
        const long L = (long)i * G + c; if (L >= nwg) return false;
        int wgid = (int)L; { const int q = nwg / NXCD, r = nwg % NXCD, xcd = wgid % NXCD, off = wgid / NXCD; wgid = (xcd < r ? xcd * (q + 1) : r * (q + 1) + (xcd - r) * q) + off; }
        const int nig = WGM * nN, gid = wgid / nig, fm = gid * WGM, gsz = (nM - fm) < WGM ? (nM - fm) : WGM;
        const int pm = fm + ((wgid % nig) % gsz), pn = (wgid % nig) / gsz;
        u.B = Bt + (size_t)pn * BM * KB; u.dst = nullptr; u.row0 = pm * BM; u.nvalid = BM; u.pn = pn; u.e = 0; u.r0 = 0; u.cnt = 0; return true;
    }
    __device__ __forceinline__ void aload(const Unit&, const int (&)[2], const int (&)[2], int (&)[2][2]) const {}
    __device__ __forceinline__ void afin(const Unit& u, const int (&R)[2], const int (&C)[2], const int (&)[2][2], unsigned (&o)[2][2]) const {
#pragma unroll
        for (int h = 0; h < 2; ++h)
#pragma unroll
            for (int i = 0; i < 2; ++i) o[h][i] = (unsigned)((u.row0 + h * HALF + R[i]) * KB + C[i] * 2);
    }
};
}

struct EpiProj {
    static constexpr bool PERM = true, BIAS_LDS = false, RS_LDS = false;
    bf16* O; const float* rstd;
    __device__ __forceinline__ void operator()(const f32x4 (&acc)[2][2][4][2], const gg::Unit& u, int wr, int wc, int fr, int fq) const {
        const int row0 = u.row0 + wr * 64 + fr, col0 = u.pn * 256 + wc * 32 + 8 * fq;
#pragma unroll
        for (int ai = 0; ai < 2; ++ai)
#pragma unroll
            for (int m = 0; m < 4; ++m) { bf16* rowp = O + (size_t)(row0 + ai * 128 + m * 16) * INC + col0; const float rs = rstd[row0 + ai * 128 + m * 16];
#pragma unroll
                for (int bj = 0; bj < 2; ++bj) { const f32x4 v0 = acc[ai][bj][m][0] * rs, v1 = acc[ai][bj][m][1] * rs;
                    v4u w; w.x = gg::cvt_pk_bf16(v0[0], v0[1]); w.y = gg::cvt_pk_bf16(v0[2], v0[3]); w.z = gg::cvt_pk_bf16(v1[0], v1[1]); w.w = gg::cvt_pk_bf16(v1[2], v1[3]);
                    *(v4u*)(rowp + bj * 128) = w; } }
    }
};
struct EpiX1 {
    static constexpr bool PERM = true, BIAS_LDS = false, RS_LDS = false;
    const bf16* X; bf16* O;
    __device__ __forceinline__ void operator()(const f32x4 (&acc)[2][2][4][2], const gg::Unit& u, int wr, int wc, int fr, int fq) const {
        const int row0 = u.row0 + wr * 64 + fr, col0 = u.pn * 256 + wc * 32 + 8 * fq;
#pragma unroll
        for (int ai = 0; ai < 2; ++ai)
#pragma unroll
            for (int m = 0; m < 4; ++m) { const size_t off = (size_t)(row0 + ai * 128 + m * 16) * D + col0;
#pragma unroll
                for (int bj = 0; bj < 2; ++bj) { const v4u xw = *(const v4u*)(X + off + bj * 128);
                    const f32x4 v0 = acc[ai][bj][m][0] + (f32x4){__uint_as_float(xw.x << 16), __uint_as_float(xw.x & 0xffff0000u), __uint_as_float(xw.y << 16), __uint_as_float(xw.y & 0xffff0000u)};
                    const f32x4 v1 = acc[ai][bj][m][1] + (f32x4){__uint_as_float(xw.z << 16), __uint_as_float(xw.z & 0xffff0000u), __uint_as_float(xw.w << 16), __uint_as_float(xw.w & 0xffff0000u)};
                    v4u w; w.x = pk2(v0[0], v0[1]); w.y = pk2(v0[2], v0[3]); w.z = pk2(v1[0], v1[1]); w.w = pk2(v1[2], v1[3]);
                    *(v4u*)(O + off + bj * 128) = w; } }
    }
};

__device__ __forceinline__ void staggered_conv(const Params& p, Frame& F, CvJob& cv, int n) { if (n > 0) { cv.run(p, F.lds + F.wave * CV_LDS, F.lane, n); } __syncthreads(); }
__device__ __forceinline__ void phase_inproj(const Params& p, Frame& F) {
    const int g = (F.bid >> 3) & 3; const int per = (CV_WGU + F.NGW - 1) / F.NGW;
    const int pre = (per * g + 1) / 3;
    CvJob cv; cv.init(0, F.gw, F.NGW, CV_WGU);
    staggered_conv(p, F, cv, pre);
    gg::DenseSched S; S.init(p.ws + WS_XN, p.ws + WS_WINT, NTOK, INC, F.G, F.bid);
    EpiProj E{(bf16*)(p.ws + WS_PROJ), (const float*)(p.ws + WS_RSTD1)};
    gg::gemm_phase<gg::DenseSched, EpiProj>(F.lds, S, E);
    __syncthreads();
    cv.rest(p, F.lds + F.wave * CV_LDS, F.lane);
}
__device__ __forceinline__ void phase_outproj(const Params& p, Frame& F) {
    const int g = (F.bid >> 3) & 3; const int per = (CV_WD_A + F.NGW - 1) / F.NGW;
    const int pre = (per * g + 1) / 3;
    CvJob cv; cv.init(2, F.gw, F.NGW, CV_WD_A);
    staggered_conv(p, F, cv, pre);
    gg::DenseSched S; S.init(p.ws + WS_MIX, p.ws + WS_WOUTT, NTOK, D, F.G, F.bid);
    EpiX1 E{(const bf16*)(p.ws + WS_XN), (bf16*)(p.ws + WS_X1B)};
    gg::gemm_phase<gg::DenseSched, EpiX1>(F.lds, S, E);
    __syncthreads();
    cv.rest(p, F.lds + F.wave * CV_LDS, F.lane);
}

__device__ __forceinline__ void load_tables(const Params& p, Frame& F, LAS int* sb) {
    unsigned* ctl = (unsigned*)(p.ws + WS_CTL);
    __syncthreads();
    if (F.tid < NE) sb[700 + F.tid] = (int)__hip_atomic_load(ctl + CW_CNT + 64 * F.tid, __ATOMIC_RELAXED, __HIP_MEMORY_SCOPE_AGENT);
    __syncthreads();
    if (F.tid == 0) {
        int acc = 0, tacc = 0;
        for (int e = 0; e < NE; ++e) { const int c = sb[700 + e]; sb[e] = acc; sb[64 + e] = tacc; acc += c; tacc += (c + 255) / 256; }
        sb[NE] = acc; sb[64 + NE] = tacc;
    }
    __syncthreads();
    { const int ntile = sb[64 + NE]; for (int t = F.tid; t < ntile; t += NTHREADS) { int e = 0; while (e < NE - 1 && sb[64 + e + 1] <= t) ++e; sb[128 + t] = e; } }
    __syncthreads();
}
__device__ __forceinline__ int lds_s(LAS const int* q) { return __builtin_amdgcn_readfirstlane(*q); }

template <int NCT, bool GATHER> struct MoeSched {
    static constexpr int KB = 1024; static constexpr bool F8 = true;
    const char* A; const char* W; const int* list; LAS const int* sb; int T, TPX, PX, x, j; unsigned char* dstbase; int dpitch;
    __device__ __forceinline__ void init(LAS const int* sb_, const Frame& F) { sb = sb_; T = lds_s(sb + 64 + NE); const int nx = (F.G % 8 == 0) ? 8 : 1; PX = F.G / nx; TPX = (T + nx - 1) / nx;
        const int c = (nx == 8) ? (F.bid % 8) * PX + F.bid / 8 : F.bid; x = c / PX; j = c % PX; }
    __device__ __forceinline__ int rounds() const { return (TPX * NCT + PX - 1) / PX; }
    __device__ __forceinline__ int rem() const { return (TPX * NCT) % PX; }
    __device__ __forceinline__ const char* abase() const { return A; }
    __device__ __forceinline__ bool next(int i, gg::Unit& u) const {
        const int m = i * PX + j, tl = m / NCT, ct = m % NCT, t = x * TPX + tl; if (tl >= TPX || t >= T) return false;
        const int e = lds_s(sb + 128 + t);
        const int base = lds_s(sb + e), cnt = lds_s(sb + e + 1) - base, r0 = (t - lds_s(sb + 64 + e)) * 256;
        u.B = W + (size_t)(e * NCT + ct) * 256 * KB; u.pn = ct; u.e = e; u.r0 = r0; u.cnt = cnt; u.row0 = base + r0; u.nvalid = (cnt - r0) < 256 ? (cnt - r0) : 256;
        u.dst = dstbase + (size_t)u.row0 * dpitch;
        return true;
    }
    __device__ __forceinline__ void aload(const gg::Unit& u, const int (&R)[2], const int (&C)[2], int (&tk)[2][2]) const {
        if (GATHER) {
#pragma unroll
            for (int h = 0; h < 2; ++h)
#pragma unroll
                for (int i = 0; i < 2; ++i) { int r = u.r0 + h * 128 + R[i]; if (r >= u.cnt) r = 0; tk[h][i] = list[u.e * NTOK + r]; }
        }
    }
    __device__ __forceinline__ void afin(const gg::Unit& u, const int (&R)[2], const int (&C)[2], const int (&tk)[2][2], unsigned (&o)[2][2]) const {
#pragma unroll
        for (int h = 0; h < 2; ++h)
#pragma unroll
            for (int i = 0; i < 2; ++i) {
                if (GATHER) o[h][i] = (unsigned)(tk[h][i] * KB + C[i] * 2);
                else o[h][i] = (unsigned)((u.row0 + h * 128 + R[i]) * KB + C[i] * 2);
            }
    }
};
#define EPI_LDS_SYNC() do { asm volatile("s_waitcnt lgkmcnt(0)" ::: "memory"); __builtin_amdgcn_s_barrier(); asm volatile("" ::: "memory"); } while (0)
__device__ __forceinline__ void ob_flush(LAS unsigned char* ob, unsigned char* dst, int rbase, int nvalid, int dpitch, int colbyte, int tid) {
#pragma unroll
    for (int hh = 0; hh < 2; ++hh) { const int row = hh * 64 + (tid >> 3), c16 = tid & 7; const v4u x = *(const LAS v4u*)(ob + row * OB_PITCH + c16 * 16);
        if (rbase + row < nvalid) *(v4u*)(dst + (unsigned)((rbase + row) * dpitch + colbyte + c16 * 16)) = x; }
}
struct EpiAct {
    static constexpr bool PERM = true, BIAS_LDS = true, RS_LDS = true;
    const float* bg; const float* bu; const float* rs; LAS unsigned char* ob; LAS unsigned char* bl; LAS unsigned char* rl;
    __device__ __forceinline__ const float* bias_src(const gg::Unit& u, int lane) const { return (lane < 32 ? bg : bu) + u.e * FF + u.pn * 128 + 4 * (lane & 31); }
    __device__ __forceinline__ const float* rs_src(const gg::Unit& u, int lane) const { return rs + (size_t)u.e * NTOK + u.r0 + 4 * lane; }
    __device__ __forceinline__ void operator()(const f32x4 (&acc)[2][2][4][2], const gg::Unit& u, int wr, int wc, int fr, int fq) const {
        const int tid = (wr * 4 + wc) * 64 + fq * 16 + fr;
        const LAS float* bs = (const LAS float*)(bl + (wr * 4 + wc) * 1024) + wc * 32 + 8 * fq;
        const f32x4 g0 = *(const LAS f32x4*)bs, g1 = *(const LAS f32x4*)(bs + 4), u0p = *(const LAS f32x4*)(bs + 128) + 1.0f, u1p = *(const LAS f32x4*)(bs + 132) + 1.0f;
        float rsv[2][4];
#pragma unroll
        for (int ai = 0; ai < 2; ++ai)
#pragma unroll
            for (int m = 0; m < 4; ++m) rsv[ai][m] = *((const LAS float*)rl + ai * 128 + wr * 64 + m * 16 + fr) * WINV;
#pragma unroll
        for (int ai = 0; ai < 2; ++ai) {
#pragma unroll
            for (int m = 0; m < 4; ++m) {
                const float sc = rsv[ai][m];
                float r[8];
#pragma unroll
                for (int n = 0; n < 2; ++n) { const f32x4 av = acc[ai][0][m][n], uv = acc[ai][1][m][n], gb4 = n ? g1 : g0, ub4 = n ? u1p : u0p;
#pragma unroll
                    for (int h = 0; h < 2; ++h) {
                        const hg2 a2 = {av[2 * h], av[2 * h + 1]}, u2 = {uv[2 * h], uv[2 * h + 1]}, gb = {gb4[2 * h], gb4[2 * h + 1]}, ub = {ub4[2 * h], ub4[2 * h + 1]};
                        hg2 gt = a2 * sc + gb; gt.x = fminf(gt.x, 7.0f); gt.y = fminf(gt.y, 7.0f);
                        const hg2 ea = gt * (-2.4554669595930157f);
                        hg2 den; den.x = ex2f_(ea.x); den.y = ex2f_(ea.y); den = den + 1.0f;
                        hg2 rc; rc.x = rcpf_(den.x); rc.y = rcpf_(den.y);
                        hg2 up1 = u2 * sc + ub;
                        up1.x = __builtin_amdgcn_fmed3f(up1.x, -6.0f, 8.0f); up1.y = __builtin_amdgcn_fmed3f(up1.y, -6.0f, 8.0f);
                        const hg2 rr = up1 * (gt * rc);
                        r[4 * n + 2 * h] = rr.x; r[4 * n + 2 * h + 1] = rr.y; } }
                v2u w; w.x = pk4_fp8(r[0], r[1], r[2], r[3]); w.y = pk4_fp8(r[4], r[5], r[6], r[7]);
                *(LAS v2u*)(ob + (wr * 64 + m * 16 + fr) * OB_PITCH + wc * 32 + 8 * fq) = w; }
            EPI_LDS_SYNC();
            ob_flush(ob, u.dst, ai * 128, u.nvalid, FF, u.pn * 128, tid);
            if (ai == 0) EPI_LDS_SYNC();
        }
    }
};
struct EpiDown {
    static constexpr bool PERM = true, BIAS_LDS = true, RS_LDS = false;
    const float* bd; LAS unsigned char* ob; LAS unsigned char* bl;
    __device__ __forceinline__ const float* bias_src(const gg::Unit& u, int lane) const { return bd + u.e * D + u.pn * 256 + 4 * lane; }
    __device__ __forceinline__ void operator()(const f32x4 (&acc)[2][2][4][2], const gg::Unit& u, int wr, int wc, int fr, int fq) const {
        const int tid = (wr * 4 + wc) * 64 + fq * 16 + fr;
        const LAS float* bs = (const LAS float*)(bl + (wr * 4 + wc) * 1024) + wc * 32 + 8 * fq;
        f32x4 bv[2][2];
#pragma unroll
        for (int bj = 0; bj < 2; ++bj) { bv[bj][0] = *(const LAS f32x4*)(bs + bj * 128); bv[bj][1] = *(const LAS f32x4*)(bs + bj * 128 + 4); }
#pragma unroll
        for (int ai = 0; ai < 2; ++ai)
#pragma unroll
            for (int bj = 0; bj < 2; ++bj) {
#pragma unroll
                for (int m = 0; m < 4; ++m) { const f32x4 v0 = acc[ai][bj][m][0] * WINV + bv[bj][0], v1 = acc[ai][bj][m][1] * WINV + bv[bj][1];
                    v2u w; w.x = pk4_fp8(v0[0], v0[1], v0[2], v0[3]); w.y = pk4_fp8(v1[0], v1[1], v1[2], v1[3]);
                    *(LAS v2u*)(ob + (wr * 64 + m * 16 + fr) * OB_PITCH + wc * 32 + 8 * fq) = w; }
                EPI_LDS_SYNC();
                ob_flush(ob, u.dst, ai * 128, u.nvalid, D, u.pn * 256 + bj * 128, tid);
                if (!(ai == 1 && bj == 1)) EPI_LDS_SYNC();
            }
    }
};
__device__ __forceinline__ int vcu_of(const Frame& F) { return (F.G % 8 == 0) ? (F.bid % 8) * (F.G / 8) + F.bid / 8 : F.bid; }
__device__ __forceinline__ void phase_gateup(const Params& p, Frame& F) {
    LAS int* sb = (LAS int*)(F.lds + LDS_TAB); load_tables(p, F, sb);
    MoeSched<8, true> S; S.A = (const char*)(p.ws + WS_H8); S.W = (const char*)(p.ws + WS_WGU8); S.list = (const int*)(p.ws + WS_LIST); S.init(sb, F);
    S.dstbase = p.ws + WS_ACT8; S.dpitch = FF;
    EpiAct E{p.b_gate, p.b_up, (const float*)(p.ws + WS_RS), F.lds + LDS_OB, F.lds + LDS_BIAS, F.lds + LDS_RS};
    gg::gemm_phase<MoeSched<8, true>, EpiAct>(F.lds, S, E);
    {
        const int rem = S.rem(), per = rem ? S.PX - rem : 0, nidle = per * (F.G / S.PX);
        __syncthreads();
        CvJob cv;
        if (nidle >= 64) { if (S.j >= rem) { cv.init(2, CV_WD_A + (S.x * per + S.j - rem) * NWAVES + F.wave, nidle * NWAVES, CV_WD); cv.rest(p, F.lds + F.wave * CV_LDS, F.lane); } }
        else { cv.init(2, CV_WD_A + F.gw, F.NGW, CV_WD); cv.rest(p, F.lds + F.wave * CV_LDS, F.lane); }
    }
}
__device__ __forceinline__ void phase_down(const Params& p, Frame& F) {
    LAS int* sb = (LAS int*)(F.lds + LDS_TAB); if (p.ph_lo > 6) load_tables(p, F, sb);
    MoeSched<4, false> S; S.A = (const char*)(p.ws + WS_ACT8); S.W = (const char*)(p.ws + WS_WD8); S.list = nullptr; S.init(sb, F);
    S.dstbase = p.ws + WS_YS; S.dpitch = D;
    EpiDown E{p.b_down, F.lds + LDS_OB, F.lds + LDS_BIAS};
    gg::gemm_phase<MoeSched<4, false>, EpiDown>(F.lds, S, E);
}

namespace hg {
constexpr int LDK = 136, LDS_ = 72, LDO = 132;
constexpr int OFF_ST = 0, OFF_QD = OFF_ST + 128 * LDK * 2, OFF_QP = OFF_QD + 64 * LDK * 2, OFF_KP = OFF_QP + 64 * LDK * 2, OFF_KDT = OFF_KP + 64 * LDK * 2,
              OFF_VT = OFF_KDT + 128 * LDS_ * 2, OFF_P = OFF_VT + 128 * LDS_ * 2, OFF_TOT = OFF_P + 64 * LDS_ * 2, OFF_DV = OFF_TOT + 4096, OFF_SQW = OFF_DV + 512, OFF_END = OFF_SQW + 2048, OFF_O = OFF_QD;
static_assert(64 * LDO * 4 <= 2 * 64 * LDK * 2 && OFF_END <= 140000, "hgrn LDS map");
typedef float f32x2 __attribute__((ext_vector_type(2)));
#define HG_LDF(off) (*(const LAS bf16x8*)(lds + (off)))
__device__ __forceinline__ f32x2 unpk2(unsigned raw) { return (f32x2){__uint_as_float(raw << 16), __uint_as_float(raw & 0xffff0000u)}; }
__device__ __forceinline__ f32x2 ex2v(f32x2 v) { return (f32x2){ex2f_(v.x), ex2f_(v.y)}; }
__device__ __forceinline__ f32x2 lg2v(f32x2 v) { return (f32x2){lg2f_(v.x), lg2f_(v.y)}; }
__device__ __forceinline__ f32x2 rcpv(f32x2 v) { return (f32x2){rcpf_(v.x), rcpf_(v.y)}; }
__device__ __forceinline__ f32x2 min2(f32x2 v, float c) { return (f32x2){fminf(v.x, c), fminf(v.y, c)}; }
__device__ __forceinline__ f32x2 sig2(f32x2 z) { return rcpv(ex2v(z * (-1.4426950408889634f)) + 1.0f); }
__device__ __forceinline__ unsigned pk2v(f32x2 v) { return pk2(v.x, v.y); }

template <bool PASS_B>
__device__ __forceinline__ void hgrn_unit(const Params& p, Frame& F, int unit, CvJob* cv) {
    LAS unsigned char* lds = F.lds;
    const bf16* PROJ = (const bf16*)(p.ws + WS_PROJ); bf16* MIX = (bf16*)(p.ws + WS_MIX);
    float* HST = (float*)(p.ws + WS_HST); float* HDEC = (float*)(p.ws + WS_HDEC);
    const int b = unit >> 6, h = (unit >> 4) & 3, seg = unit & 15;
    const int lane = F.lane, w = F.wave, fr = lane & 15, q = lane >> 4, cp = lane, tg = w;
    const int ch = h * HD + 2 * cp;
    f32x2 lb2; { const float a0 = p.hgrn_lb[ch], a1 = p.hgrn_lb[HW + ch], c0 = p.hgrn_lb[ch + 1], c1 = p.hgrn_lb[HW + ch + 1]; lb2.x = rcpf_(1.0f + __expf(a1 - a0)); lb2.y = rcpf_(1.0f + __expf(c1 - c0)); }
    const f32x2 oml2 = 1.0f - lb2;
    const f32x2 ng2 = {p.hgrn_norm_g[2 * cp], p.hgrn_norm_g[2 * cp + 1]};
    f32x4 acc_s[8];
#pragma unroll
    for (int kt = 0; kt < 8; ++kt) acc_s[kt] = (f32x4){0.f, 0.f, 0.f, 0.f};
    f32x2 segsum2 = {0.f, 0.f};
    if (PASS_B) {
        LAS float* Wt = (LAS float*)(lds + OFF_QD);
        if (F.tid < 128) { float dv[15];
#pragma unroll
            for (int j = 0; j < 15; ++j) dv[j] = (j < seg) ? HDEC[(unit - seg + j) * 128 + F.tid] : 1.0f;
            float run = 1.0f;
#pragma unroll
            for (int j = 14; j >= 0; --j) if (j < seg) { Wt[j * 128 + F.tid] = run; run *= dv[j]; } }
        LDS_SYNC();
        for (int j0 = 0; j0 < seg; j0 += 5) {
            v4u e4[5][4];
#pragma unroll
            for (int u = 0; u < 5; ++u) { const int j = (j0 + u < seg) ? j0 + u : seg - 1; const unsigned char* hs = (const unsigned char*)HST + (size_t)(unit - seg + j) * 32768 + (size_t)w * 4096 + lane * 16;
#pragma unroll
                for (int kp = 0; kp < 4; ++kp) e4[u][kp] = *(const v4u*)(hs + kp * 1024); }
#pragma unroll
            for (int u = 0; u < 5; ++u) { const bool ok = j0 + u < seg; const int j = ok ? j0 + u : seg - 1;
#pragma unroll
                for (int kt = 0; kt < 8; ++kt) { f32x4 w4 = *(const LAS f32x4*)(Wt + j * 128 + 16 * kt + 4 * q); if (!ok) w4 = (f32x4){0.f, 0.f, 0.f, 0.f};
                    const unsigned r0 = (kt & 1) ? e4[u][kt >> 1].z : e4[u][kt >> 1].x, r1 = (kt & 1) ? e4[u][kt >> 1].w : e4[u][kt >> 1].y;
                    const f32x4 ev = {__uint_as_float(r0 << 16), __uint_as_float(r0 & 0xffff0000u), __uint_as_float(r1 << 16), __uint_as_float(r1 & 0xffff0000u)};
                    acc_s[kt] = acc_s[kt] + w4 * ev; } } }
        LDS_SYNC();
#pragma unroll
        for (int kt = 0; kt < 8; ++kt) { v2u wv; wv.x = pk2(acc_s[kt][0], acc_s[kt][1]); wv.y = pk2(acc_s[kt][2], acc_s[kt][3]); *(LAS v2u*)(lds + OFF_ST + ((16 * w + fr) * LDK + 16 * kt + 4 * q) * 2) = wv; }
    }
    unsigned nq[8], nf[8], nv[8], ngr[8];
    if (PASS_B) { const bf16* base = PROJ + (size_t)(b * SEQ + seg * 512 + 8 * tg) * INC + ch;
#pragma unroll
      for (int i = 0; i < 8; ++i) { const bf16* r = base + (size_t)i * INC; nf[i] = *(const unsigned*)(r + HW); nv[i] = *(const unsigned*)(r + 2 * HW); nq[i] = *(const unsigned*)r; ngr[i] = *(const unsigned*)(r + 3 * HW); } }
    for (int c = 0; c < 8; ++c) {
        const int row0 = b * SEQ + seg * 512 + c * 64 + 8 * tg;
        unsigned qraw[8], fraw[8], vraw[8], graw[8];
        if (PASS_B) {
#pragma unroll
            for (int i = 0; i < 8; ++i) { qraw[i] = nq[i]; fraw[i] = nf[i]; vraw[i] = nv[i]; graw[i] = ngr[i]; }
            if (c < 7) { const bf16* base = PROJ + (size_t)(row0 + 64) * INC + ch;
#pragma unroll
                for (int i = 0; i < 8; ++i) { const bf16* r = base + (size_t)i * INC; nf[i] = *(const unsigned*)(r + HW); nv[i] = *(const unsigned*)(r + 2 * HW); nq[i] = *(const unsigned*)r; ngr[i] = *(const unsigned*)(r + 3 * HW); } }
        } else {
            const bf16* base = PROJ + (size_t)row0 * INC + ch;
#pragma unroll
            for (int i = 0; i < 8; ++i) { const bf16* r = base + (size_t)i * INC; fraw[i] = *(const unsigned*)(r + HW); vraw[i] = *(const unsigned*)(r + 2 * HW); qraw[i] = 0u; graw[i] = 0u; }
#pragma unroll
            for (int i = 0; i < 8; ++i) asm volatile("" : "+v"(fraw[i]), "+v"(vraw[i]));
            if (cv) cv->top(p, lane);
        }
        f32x2 k2[8], b2[8];
        { f32x2 s2 = {0.f, 0.f};
#pragma unroll
          for (int i = 0; i < 8; ++i) { const f32x2 f2 = lb2 + oml2 * sig2(unpk2(fraw[i])); k2[i] = 1.0f - f2; s2 += lg2v(f2); b2[i] = s2; }
          *(LAS f32x2*)(lds + OFF_TOT + (tg * 128 + 2 * cp) * 4) = s2; }
        LDS_SYNC();
        f32x2 off2 = {0.f, 0.f}, bl2 = {0.f, 0.f}, bm2 = {0.f, 0.f};
#pragma unroll
        for (int g = 0; g < 8; ++g) { const f32x2 t2 = *(const LAS f32x2*)(lds + OFF_TOT + (g * 128 + 2 * cp) * 4); if (g < tg) off2 += t2; if (g < 4) bm2 += t2; bl2 += t2; }
        segsum2 += bl2;
        if (tg == 0) *(LAS f32x2*)(lds + OFF_DV + 2 * cp * 4) = ex2v(bl2);
        const f32x2 cq2 = ex2v(bm2), ck2 = ex2v(bl2 - bm2);
        { unsigned kd0[8], kd1[8], vv0[8], vv1[8];
#pragma unroll
          for (int i = 0; i < 8; ++i) { const f32x2 bb2 = off2 + b2[i];
              vv0[i] = vraw[i] & 0xffffu; vv1[i] = vraw[i] >> 16;
              unsigned kk;
              if (PASS_B) { const f32x2 qp = unpk2(qraw[i]); const f32x2 q2 = qp * sig2(qp);
                  const int t = 8 * tg + i;
                  const f32x2 qe = q2 * ex2v(min2(bb2 - bm2, 115.f)), ke = k2[i] * ex2v(min2(bm2 - bb2, 115.f));
                  *(LAS unsigned*)(lds + OFF_QD + (t * LDK + 2 * cp) * 2) = pk2v(qe * cq2);
                  *(LAS unsigned*)(lds + OFF_QP + (t * LDK + 2 * cp) * 2) = pk2v(qe);
                  *(LAS unsigned*)(lds + OFF_KP + (t * LDK + 2 * cp) * 2) = pk2v(ke);
                  kk = pk2v(ke * ck2); }
              else kk = pk2v(k2[i] * ex2v(bl2 - bb2));
              kd0[i] = kk & 0xffffu; kd1[i] = kk >> 16; }
          v4u x; x.x = kd0[0] | (kd0[1] << 16); x.y = kd0[2] | (kd0[3] << 16); x.z = kd0[4] | (kd0[5] << 16); x.w = kd0[6] | (kd0[7] << 16); *(LAS v4u*)(lds + OFF_KDT + ((2 * cp) * LDS_ + 8 * tg) * 2) = x;
          x.x = kd1[0] | (kd1[1] << 16); x.y = kd1[2] | (kd1[3] << 16); x.z = kd1[4] | (kd1[5] << 16); x.w = kd1[6] | (kd1[7] << 16); *(LAS v4u*)(lds + OFF_KDT + ((2 * cp + 1) * LDS_ + 8 * tg) * 2) = x;
          x.x = vv0[0] | (vv0[1] << 16); x.y = vv0[2] | (vv0[3] << 16); x.z = vv0[4] | (vv0[5] << 16); x.w = vv0[6] | (vv0[7] << 16); *(LAS v4u*)(lds + OFF_VT + ((2 * cp) * LDS_ + 8 * tg) * 2) = x;
          x.x = vv1[0] | (vv1[1] << 16); x.y = vv1[2] | (vv1[3] << 16); x.z = vv1[4] | (vv1[5] << 16); x.w = vv1[6] | (vv1[7] << 16); *(LAS v4u*)(lds + OFF_VT + ((2 * cp + 1) * LDS_ + 8 * tg) * 2) = x; }
        LDS_SYNC();
        f32x4 acc_o[4];
        if (PASS_B) {
#pragma unroll
            for (int ti = 0; ti < 4; ++ti) acc_o[ti] = (f32x4){0.f, 0.f, 0.f, 0.f};
#pragma unroll
            for (int ks = 0; ks < 4; ++ks) { const bf16x8 a = HG_LDF(OFF_ST + ((16 * w + fr) * LDK + 32 * ks + 8 * q) * 2);
#pragma unroll
                for (int ti = 0; ti < 4; ++ti) { const bf16x8 bq = HG_LDF(OFF_QD + ((16 * ti + fr) * LDK + 32 * ks + 8 * q) * 2); acc_o[ti] = __builtin_amdgcn_mfma_f32_16x16x32_bf16(a, bq, acc_o[ti], 0, 0, 0); } }
            { const int ti = w >> 1;
#pragma unroll
              for (int sj = 0; sj < 2; ++sj) { const int si = 2 * (w & 1) + sj; f32x4 ap = (f32x4){0.f, 0.f, 0.f, 0.f};
                  if (si <= ti) {
#pragma unroll
                      for (int ks = 0; ks < 4; ++ks) { const bf16x8 a = HG_LDF(OFF_KP + ((16 * si + fr) * LDK + 32 * ks + 8 * q) * 2), bq = HG_LDF(OFF_QP + ((16 * ti + fr) * LDK + 32 * ks + 8 * q) * 2);
                          ap = __builtin_amdgcn_mfma_f32_16x16x32_bf16(a, bq, ap, 0, 0, 0); } }
                  const int t = 16 * ti + fr, s0 = 16 * si + 4 * q;
                  const float p0 = (si <= ti && s0 + 0 <= t) ? ap[0] : 0.f, p1 = (si <= ti && s0 + 1 <= t) ? ap[1] : 0.f, p2 = (si <= ti && s0 + 2 <= t) ? ap[2] : 0.f, p3 = (si <= ti && s0 + 3 <= t) ? ap[3] : 0.f;
                  v2u wv; wv.x = pk2(p0, p1); wv.y = pk2(p2, p3); *(LAS v2u*)(lds + OFF_P + (t * LDS_ + s0) * 2) = wv; } }
            LDS_SYNC();
        }
        { bf16x8 vt[2];
#pragma unroll
          for (int ss = 0; ss < 2; ++ss) vt[ss] = HG_LDF(OFF_VT + ((16 * w + fr) * LDS_ + 32 * ss + 8 * q) * 2);
          if (PASS_B) {
#pragma unroll
              for (int ss = 0; ss < 2; ++ss)
#pragma unroll
                  for (int ti = 0; ti < 4; ++ti) { if (ss == 1 && ti < 2) continue; const bf16x8 bp = HG_LDF(OFF_P + ((16 * ti + fr) * LDS_ + 32 * ss + 8 * q) * 2); acc_o[ti] = __builtin_amdgcn_mfma_f32_16x16x32_bf16(vt[ss], bp, acc_o[ti], 0, 0, 0); }
          }
#pragma unroll
          for (int kt = 0; kt < 8; ++kt) { const f32x4 d4 = *(const LAS f32x4*)(lds + OFF_DV + (16 * kt + 4 * q) * 4); acc_s[kt] = acc_s[kt] * d4;
#pragma unroll
              for (int ss = 0; ss < 2; ++ss) { const bf16x8 a = HG_LDF(OFF_KDT + ((16 * kt + fr) * LDS_ + 32 * ss + 8 * q) * 2); acc_s[kt] = __builtin_amdgcn_mfma_f32_16x16x32_bf16(a, vt[ss], acc_s[kt], 0, 0, 0); } }
        }
        if (PASS_B) {
#pragma unroll
            for (int ti = 0; ti < 4; ++ti) { *(LAS f32x4*)(lds + OFF_O + ((16 * ti + fr) * LDO + 16 * w + 4 * q) * 4) = acc_o[ti];
                float sq = (acc_o[ti][0] * acc_o[ti][0] + acc_o[ti][1] * acc_o[ti][1]) + (acc_o[ti][2] * acc_o[ti][2] + acc_o[ti][3] * acc_o[ti][3]);
                sq += __shfl_xor(sq, 16); sq += __shfl_xor(sq, 32);
                if (q == 0) *(LAS float*)(lds + OFF_SQW + ((16 * ti + fr) * 8 + w) * 4) = sq; }
#pragma unroll
            for (int kt = 0; kt < 8; ++kt) { v2u wv; wv.x = pk2(acc_s[kt][0], acc_s[kt][1]); wv.y = pk2(acc_s[kt][2], acc_s[kt][3]); *(LAS v2u*)(lds + OFF_ST + ((16 * w + fr) * LDK + 16 * kt + 4 * q) * 2) = wv; }
            LDS_SYNC();
#pragma unroll
            for (int i = 0; i < 8; ++i) { const int t = 8 * tg + i; const f32x2 o2 = *(const LAS f32x2*)(lds + OFF_O + (t * LDO + 2 * cp) * 4);
                const f32x4 sa = *(const LAS f32x4*)(lds + OFF_SQW + t * 32), sb4 = *(const LAS f32x4*)(lds + OFF_SQW + t * 32 + 16);
                const float ss = ((sa[0] + sa[1]) + (sa[2] + sa[3])) + ((sb4[0] + sb4[1]) + (sb4[2] + sb4[3])); const float rstd = rsqf_(ss * (1.0f / HD) + EPS);
                const f32x2 gv = unpk2(graw[i]);
                *(unsigned*)(MIX + (size_t)(row0 + i) * D + ch) = pk2v(o2 * rstd * ng2 * (gv * sig2(gv))); }
        }
        if (!PASS_B && cv) cv->bottom(lds + OFF_ST + w * CV_LDS, lane);
    }
    if (!PASS_B) {
        unsigned char* hs = (unsigned char*)HST + (size_t)unit * 32768 + (size_t)w * 4096 + lane * 16;
#pragma unroll
        for (int kp = 0; kp < 4; ++kp) { v4u wv; wv.x = pk2(acc_s[2 * kp][0], acc_s[2 * kp][1]); wv.y = pk2(acc_s[2 * kp][2], acc_s[2 * kp][3]); wv.z = pk2(acc_s[2 * kp + 1][0], acc_s[2 * kp + 1][1]); wv.w = pk2(acc_s[2 * kp + 1][2], acc_s[2 * kp + 1][3]);
            *(v4u*)(hs + kp * 1024) = wv; }
        if (tg == 0) *(f32x2*)(HDEC + unit * 128 + 2 * cp) = ex2v(segsum2);
    }
    LDS_SYNC();
}

__device__ __forceinline__ void pool_unit(const Params& p, Frame& F, int unit) {
    LAS unsigned char* lds = F.lds;
    const bf16* PROJ = (const bf16*)(p.ws + WS_PROJ); bf16* MIX = (bf16*)(p.ws + WS_MIX); const bf16* POOLT = (const bf16*)(p.ws + WS_POOLT);
    const int lane = F.lane, w = F.wave, fr = lane & 15, q = lane >> 4, cp = lane, tg = w;
    const int tok0 = unit * 64, t0 = tok0 + 8 * tg, s0 = t0 % SEQ;
#pragma unroll
    for (int g = 0; g < 4; ++g) {
        constexpr int dummy = 0; (void)dummy;
        const int win = 2 << g;
        const bf16* col = PROJ + (size_t)t0 * INC + 4 * HW + g * 128 + 2 * cp;
        float u0[23], u1[23];
#pragma unroll
        for (int j = 0; j < 23; ++j) { if (j < 8 + win - 1) { const int rel = j - (win - 1); unsigned raw = 0u; if (s0 + rel >= 0) raw = *(const unsigned*)(col + (ptrdiff_t)rel * INC); u0[j] = bf2f(raw & 0xffffu); u1[j] = bf2f(raw >> 16); } else { u0[j] = 0.f; u1[j] = 0.f; } }
#pragma unroll
        for (int i = 0; i < 8; ++i) { float a0 = 0.f, a1 = 0.f;
#pragma unroll
            for (int jj = 0; jj < 16; ++jj) if (jj < win) { a0 += u0[i + jj]; a1 += u1[i + jj]; }
            const int n = (s0 + i + 1 < win) ? (s0 + i + 1) : win; const float inv = rcpf_((float)n);
            *(LAS unsigned*)(lds + ((8 * tg + i) * hg::LDK + 2 * cp) * 2) = pk2(a0 * inv - u0[i + win - 1], a1 * inv - u1[i + win - 1]); }
        LDS_SYNC();
        f32x4 acc[4];
#pragma unroll
        for (int ti = 0; ti < 4; ++ti) acc[ti] = (f32x4){0.f, 0.f, 0.f, 0.f};
#pragma unroll
        for (int ks = 0; ks < 4; ++ks) { const bf16x8 a = *(const bf16x8*)(POOLT + (size_t)g * 16384 + (16 * w + fr) * 128 + 32 * ks + 8 * q);
#pragma unroll
            for (int ti = 0; ti < 4; ++ti) { const bf16x8 bq = *(const LAS bf16x8*)(lds + ((16 * ti + fr) * hg::LDK + 32 * ks + 8 * q) * 2); acc[ti] = __builtin_amdgcn_mfma_f32_16x16x32_bf16(a, bq, acc[ti], 0, 0, 0); } }
        const f32x4 sc = *(const f32x4*)(p.pool_scale + g * 128 + 16 * w + 4 * q);
#pragma unroll
        for (int ti = 0; ti < 4; ++ti) { v2u wv; wv.x = pk2(acc[ti][0] * sc[0], acc[ti][1] * sc[1]); wv.y = pk2(acc[ti][2] * sc[2], acc[ti][3] * sc[3]);
            *(v2u*)(MIX + (size_t)(tok0 + 16 * ti + fr) * D + HW + g * 128 + 16 * w + 4 * q) = wv; }
        LDS_SYNC();
    }
}
}
__device__ __forceinline__ int hgrn_unit_of(int u, int G) { if (G != 256) return u; const int x = u & 7, jj = u >> 3; return ((2 * x + (jj >> 4)) << 4) | (jj & 15); }
__device__ __forceinline__ void phase_mixA(const Params& p, Frame& F) {
    for (int u = F.bid; u < 256; u += F.G) hg::hgrn_unit<false>(p, F, hgrn_unit_of(u, F.G), nullptr);
    for (int u = F.bid; u < NTOK / 64; u += F.G) hg::pool_unit(p, F, u);
}
__device__ __forceinline__ void phase_mixB(const Params& p, Frame& F) {
    for (int u = F.bid; u < 256; u += F.G) hg::hgrn_unit<true>(p, F, hgrn_unit_of(u, F.G), nullptr);
}

namespace rt {
constexpr int LG_STRIDE = 33;
constexpr int SLAB = 128 * LG_STRIDE * 4, OFF_LGW = 0, OFF_SQW = OFF_LGW + 8 * SLAB, OFF_SQ = OFF_SQW + 8 * 128 * 4, OFF_TE = OFF_SQ + 512, OFF_TG = OFF_TE + 2048, OFF_CNT = OFF_TG + 2048, OFF_BASE = OFF_CNT + 128,
              OFF_HS = OFF_BASE + 128, OFF_END = OFF_HS + 8 * 2304;
static_assert(OFF_END <= LDS_BYTES - 64, "route LDS map");
__device__ __forceinline__ void split8(const f32x4 a, const f32x4 b, bf16x8& hi, bf16x8& lo) {
    const float v[8] = {a[0], a[1], a[2], a[3], b[0], b[1], b[2], b[3]};
    unsigned h[4], l[4];
#pragma unroll
    for (int j = 0; j < 4; ++j) { h[j] = pk2(v[2 * j], v[2 * j + 1]); l[j] = pk2(v[2 * j] - __uint_as_float(h[j] << 16), v[2 * j + 1] - __uint_as_float(h[j] & 0xffff0000u)); }
    hi = __builtin_bit_cast(bf16x8, (v4u){h[0], h[1], h[2], h[3]}); lo = __builtin_bit_cast(bf16x8, (v4u){l[0], l[1], l[2], l[3]});
}
}
__device__ __forceinline__ void phase_route(const Params& p, Frame& F) {
    LAS unsigned char* lds = F.lds;
    unsigned char* H8 = p.ws + WS_H8; unsigned* ctl = (unsigned*)(p.ws + WS_CTL); const bf16* X1B = (const bf16*)(p.ws + WS_X1B);
    int* LIST = (int*)(p.ws + WS_LIST); int* TOKES = (int*)(p.ws + WS_TOKES); float* TOKG = (float*)(p.ws + WS_TOKGATE);
    const bf16* WRH = (const bf16*)(p.ws + WS_WRH); const bf16* WRL = (const bf16*)(p.ws + WS_WRL); float* RS = (float*)(p.ws + WS_RS);
    const int lane = F.lane, w = F.wave, fr = lane & 15, q = lane >> 4, tid = F.tid;
    f32x4 g2a[4], g2b[4];
#pragma unroll
    for (int ks = 0; ks < 4; ++ks) { g2a[ks] = *(const f32x4*)(p.norm2_g + 128 * w + 32 * ks + 8 * q); g2b[ks] = *(const f32x4*)(p.norm2_g + 128 * w + 32 * ks + 8 * q + 4); }
    LAS unsigned char* hs = lds + rt::OFF_HS + w * 2304;
    bf16x8 wh[2][4], wl[2][4];
#pragma unroll
    for (int nt = 0; nt < 2; ++nt)
#pragma unroll
        for (int ks = 0; ks < 4; ++ks) { const size_t o = (size_t)(16 * nt + fr) * D + 128 * w + 32 * ks + 8 * q; wh[nt][ks] = *(const bf16x8*)(WRH + o); wl[nt][ks] = *(const bf16x8*)(WRL + o); }
    LAS float* LGW = (LAS float*)(lds + rt::OFF_LGW); LAS float* SQW = (LAS float*)(lds + rt::OFF_SQW); LAS float* SQ = (LAS float*)(lds + rt::OFF_SQ);
    LAS float* const lgw = LGW + w * (rt::SLAB / 4); LAS int* TE = (LAS int*)(lds + rt::OFF_TE); LAS float* TG = (LAS float*)(lds + rt::OFF_TG);
    LAS int* CNT = (LAS int*)(lds + rt::OFF_CNT); LAS int* BASE = (LAS int*)(lds + rt::OFF_BASE);
    const int nround = (NTOK / 128 + F.G - 1) / F.G;
    for (int it = 0; it < nround; ++it) {
        const int blk = it * F.G + F.bid; const bool active = blk < NTOK / 128; const int tok0 = blk * 128;
        __syncthreads();
        if (tid < 32) CNT[tid] = 0;
        __syncthreads();
        if (active) {
            v4u xa[4];
            { const bf16* xr = X1B + (size_t)(tok0 + 16 * w + fr) * D + 128 * w + 8 * q;
#pragma unroll
              for (int ks = 0; ks < 4; ++ks) xa[ks] = *(const v4u*)(xr + 32 * ks); }
#pragma unroll 1
            for (int ii = 0; ii < 8; ++ii) {
                const int i = (ii + w) & 7;
                v4u ca[4];
#pragma unroll
                for (int ks = 0; ks < 4; ++ks) ca[ks] = xa[ks];
                if (ii < 7) { const bf16* xr = X1B + (size_t)(tok0 + 16 * ((i + 1) & 7) + fr) * D + 128 * w + 8 * q;
#pragma unroll
                    for (int ks = 0; ks < 4; ++ks) xa[ks] = *(const v4u*)(xr + 32 * ks); }
                f32x4 acc0 = {0.f, 0.f, 0.f, 0.f}, acc1 = {0.f, 0.f, 0.f, 0.f}; float sq = 0.f;
#pragma unroll
                for (int ks = 0; ks < 4; ++ks) { const v4u xw = ca[ks];
                    const f32x4 a = {__uint_as_float(xw.x << 16), __uint_as_float(xw.x & 0xffff0000u), __uint_as_float(xw.y << 16), __uint_as_float(xw.y & 0xffff0000u)};
                    const f32x4 b = {__uint_as_float(xw.z << 16), __uint_as_float(xw.z & 0xffff0000u), __uint_as_float(xw.w << 16), __uint_as_float(xw.w & 0xffff0000u)};
                    sq += (a[0] * a[0] + a[1] * a[1]) + (a[2] * a[2] + a[3] * a[3]) + (b[0] * b[0] + b[1] * b[1]) + (b[2] * b[2] + b[3] * b[3]);
                    { const f32x4 ya = a * g2a[ks], yb = b * g2b[ks]; v2u hw; hw.x = pk4_fp8(ya[0], ya[1], ya[2], ya[3]); hw.y = pk4_fp8(yb[0], yb[1], yb[2], yb[3]);
                      *(LAS v2u*)(hs + fr * 144 + 32 * ks + 8 * q) = hw; }
                    const bf16x8 xh = __builtin_bit_cast(bf16x8, xw);
                    acc0 = __builtin_amdgcn_mfma_f32_16x16x32_bf16(xh, wh[0][ks], acc0, 0, 0, 0); acc0 = __builtin_amdgcn_mfma_f32_16x16x32_bf16(xh, wl[0][ks], acc0, 0, 0, 0);
                    acc1 = __builtin_amdgcn_mfma_f32_16x16x32_bf16(xh, wh[1][ks], acc1, 0, 0, 0); acc1 = __builtin_amdgcn_mfma_f32_16x16x32_bf16(xh, wl[1][ks], acc1, 0, 0, 0); }
                asm volatile("s_waitcnt lgkmcnt(0)" ::: "memory");
#pragma unroll
                for (int hh = 0; hh < 2; ++hh) { const int row = (lane >> 3) + 8 * hh, c16 = lane & 7; const v4u hv = *(const LAS v4u*)(hs + row * 144 + 16 * c16);
                    *(v4u*)(H8 + (size_t)(tok0 + 16 * i + row) * D + 128 * w + 16 * c16) = hv; }
                asm volatile("s_waitcnt lgkmcnt(0)" ::: "memory");
                sq += __shfl_xor(sq, 16); sq += __shfl_xor(sq, 32);
                if (q == 0) SQW[w * 128 + 16 * i + fr] = sq;
#pragma unroll
                for (int r = 0; r < 4; ++r) { lgw[(16 * i + 4 * q + r) * rt::LG_STRIDE + fr] = acc0[r]; lgw[(16 * i + 4 * q + r) * rt::LG_STRIDE + 16 + fr] = acc1[r]; }
            }
        }
        __syncthreads();
        if (active && tid < 128) {
            float ss = 0.f;
#pragma unroll
            for (int w8 = 0; w8 < 8; ++w8) ss += SQW[w8 * 128 + tid];
            const float rstd = rsqf_(ss * (1.0f / D) + EPS); SQ[tid] = rstd;
            float v[32];
#pragma unroll
            for (int e = 0; e < 32; ++e) { float a = 0.f;
#pragma unroll
                for (int w8 = 0; w8 < 8; ++w8) a += LGW[w8 * (rt::SLAB / 4) + tid * rt::LG_STRIDE + e];
                v[e] = a * rstd + p.router_b[e]; }
            float tv[4]; int te[4];
#pragma unroll
            for (int r = 0; r < 4; ++r) { float bv = -INFINITY; int bi = 0;
#pragma unroll
                for (int e = 0; e < 32; ++e) { if (v[e] > bv) { bv = v[e]; bi = e; } }
                tv[r] = bv; te[r] = bi;
#pragma unroll
                for (int e = 0; e < 32; ++e) if (e == bi) v[e] = -INFINITY; }
            const float e1 = __expf(tv[1] - tv[0]), e2 = __expf(tv[2] - tv[0]), e3 = __expf(tv[3] - tv[0]); const float inv = 1.0f / (1.0f + e1 + e2 + e3);
            TE[tid * 4 + 0] = te[0]; TE[tid * 4 + 1] = te[1]; TE[tid * 4 + 2] = te[2]; TE[tid * 4 + 3] = te[3];
            TG[tid * 4 + 0] = inv; TG[tid * 4 + 1] = e1 * inv; TG[tid * 4 + 2] = e2 * inv; TG[tid * 4 + 3] = e3 * inv;
        }
        __syncthreads();
        int ee = 0, lrank = 0;
        if (active) { ee = TE[tid]; lrank = __hip_atomic_fetch_add(CNT + ee, 1, __ATOMIC_RELAXED, __HIP_MEMORY_SCOPE_WORKGROUP); }
        __syncthreads();
        if (active && tid < 32) { const int c = CNT[tid]; BASE[tid] = c ? (int)atomicAdd(ctl + CW_CNT + 64 * tid, (unsigned)c) : 0; }
        __syncthreads();
        if (active) { const int tok = tok0 + (tid >> 2), slot = BASE[ee] + lrank;
            LIST[ee * NTOK + slot] = tok; TOKES[tok * 4 + (tid & 3)] = (ee << 16) | slot; TOKG[tok * 4 + (tid & 3)] = TG[tid]; RS[ee * NTOK + slot] = SQ[tid >> 2]; }
    }
}

constexpr int N_PHASES = 9;
constexpr unsigned DUP_MASK = 0x000u;
__global__ void __launch_bounds__(NTHREADS, 2) fwd(Params p) {
    extern __shared__ __attribute__((aligned(16))) unsigned char lds[];
    Frame F; F.lds = (LAS unsigned char*)lds; F.tid = threadIdx.x; F.lane = F.tid & 63; F.wave = __builtin_amdgcn_readfirstlane(F.tid >> 6);
    F.G = gridDim.x; F.bid = blockIdx.x; F.gw = F.bid * NWAVES + F.wave; F.NGW = F.G * NWAVES;
    volatile LAS unsigned* MISC = (volatile LAS unsigned*)(F.lds + LDS_BYTES - 64);
    if (F.tid < 16) MISC[F.tid] = 0u;
    __syncthreads();
    const int lo = p.ph_lo, hi = p.ph_hi;
    XcdBarrier bar; bar.bar = (unsigned*)(p.ws + WS_CTL) + CW_BAR; bar.x = 0; bar.st = nullptr;
    if (hi - lo > 1) bar = xcd_barrier_post((unsigned*)(p.ws + WS_CTL) + CW_BAR, MISC + 8);
#define IN(k) (lo <= (k) && (k) < hi)
#define SEAM(k) do { if (IN(k) && IN((k) + 1)) xcd_barrier(bar); } while (0)
#define RUN(k, call) do { if (IN(k)) { call; if ((DUP_MASK >> (k)) & 1u) { __syncthreads(); call; } } } while (0)
    RUN(0, phase_prep(p, F)); SEAM(0);
    RUN(1, phase_inproj(p, F)); SEAM(1);
    RUN(2, phase_mixA(p, F)); SEAM(2);
    RUN(3, phase_mixB(p, F)); SEAM(3);
    RUN(4, phase_outproj(p, F)); SEAM(4);
    RUN(5, phase_route(p, F)); SEAM(5);
    RUN(6, phase_gateup(p, F)); SEAM(6);
    RUN(7, phase_down(p, F)); SEAM(7);
    RUN(8, phase_final(p, F));
#undef RUN
#undef IN
#undef SEAM
}

extern "C" void kernel_launch(void* const* d_in, const int* in_sizes, int n_in, void* d_out, int out_size, void* d_ws, size_t ws_size, hipStream_t stream) {
    static int grid = 0;
    if (grid == 0) {
        if (n_in != 18 || in_sizes[0] != NTOK * D || out_size != NTOK * D || ws_size < WS_END) {
            fprintf(stderr, "kernel_launch: unexpected shapes / workspace (n_in %d, in0 %d, out %d, ws %zu, need %zu); nothing launched\n", n_in, n_in > 0 ? in_sizes[0] : -1, out_size, ws_size, (size_t)WS_END);
            grid = -1; return; }
        int dev = 0, cus = 0;
        if (hipGetDevice(&dev) != hipSuccess || hipDeviceGetAttribute(&cus, hipDeviceAttributeMultiprocessorCount, dev) != hipSuccess) { grid = -1; return; }
        if (hipFuncSetAttribute((const void*)fwd, hipFuncAttributeMaxDynamicSharedMemorySize, LDS_BYTES) != hipSuccess) { fprintf(stderr, "kernel_launch: hipFuncSetAttribute failed\n"); grid = -1; return; }
        int per_cu = 0;
        if (hipOccupancyMaxActiveBlocksPerMultiprocessor(&per_cu, (const void*)fwd, NTHREADS, LDS_BYTES) != hipSuccess || per_cu < 1) fprintf(stderr, "kernel_launch: occupancy query says %d\n", per_cu);
        (void)hipGetLastError();
        grid = cus;
    }
    if (grid < 0) return;
    (void)hipMemsetAsync((char*)d_ws + WS_CTL, 0, CTL_ZERO_BYTES, stream);
    Params p{};
    p.x = (const float*)d_in[0]; p.norm1_g = (const float*)d_in[1]; p.w_in = (const float*)d_in[2]; p.hgrn_lb = (const float*)d_in[3]; p.hgrn_norm_g = (const float*)d_in[4];
    p.pool_w = (const float*)d_in[5]; p.pool_scale = (const float*)d_in[6]; p.w_out = (const float*)d_in[7]; p.norm2_g = (const float*)d_in[8]; p.router_w = (const float*)d_in[9];
    p.router_b = (const float*)d_in[10]; p.w_gate = (const float*)d_in[11]; p.b_gate = (const float*)d_in[12]; p.w_up = (const float*)d_in[13]; p.b_up = (const float*)d_in[14];
    p.w_down = (const float*)d_in[15]; p.b_down = (const float*)d_in[16]; p.norm_f_g = (const float*)d_in[17];
    p.out = (float*)d_out; p.ws = (unsigned char*)d_ws;
#if MK_PER_PHASE
    for (int k = 0; k < N_PHASES; ++k) { p.ph_lo = k; p.ph_hi = k + 1; hipLaunchKernelGGL(fwd, dim3(grid), dim3(NTHREADS), LDS_BYTES, stream, p); }
#else
    p.ph_lo = 0; p.ph_hi = N_PHASES; hipLaunchKernelGGL(fwd, dim3(grid), dim3(NTHREADS), LDS_BYTES, stream, p);
#endif
}
```

```cpp
#include <hip/hip_runtime.h>
#include <cstdio>
#include <cstdint>

#define LAS __attribute__((address_space(3)))
#define GAS __attribute__((address_space(1)))
typedef unsigned short bf16;
typedef short bf16x8 __attribute__((ext_vector_type(8)));
typedef float f32x4 __attribute__((ext_vector_type(4)));
typedef unsigned v4u __attribute__((ext_vector_type(4)));
typedef unsigned v2u __attribute__((ext_vector_type(2)));

#ifndef MK_PER_PHASE
#define MK_PER_PHASE 0
#endif

constexpr int NB = 4, SEQ = 8192, D = 1024, NTOK = NB * SEQ, INC = 2560, HW = 512, NH = 4, HD = 128;
constexpr int NE = 32, TOPK = 4, NROWS = NTOK * TOPK, FF = 1024;
constexpr float EPS = 1e-6f;
constexpr int NTHREADS = 512, NWAVES = 8;
constexpr int LDS_BYTES = 163840;
constexpr int LDS_TAB = 131072, LDS_OB = 134144, OB_PITCH = 144, LDS_BIAS = 153600, LDS_RS = 161792;

constexpr size_t KiB = 1024, MiB = 1024 * 1024;
constexpr size_t WS_CTL = 0, CTL_ZERO_BYTES = 64 * KiB;
constexpr size_t WS_POOLT = 512 * KiB;
constexpr size_t WS_WRH = 768 * KiB, WS_WRL = 832 * KiB;
constexpr size_t WS_WINT = 1 * MiB;
constexpr size_t WS_LIST = 1 * MiB;
constexpr size_t WS_TOKES = 5 * MiB;
constexpr size_t WS_TOKGATE = 5 * MiB + 512 * KiB;
constexpr size_t WS_WOUTT = 6 * MiB;
constexpr size_t WS_WD8 = 8 * MiB;
constexpr size_t WS_WGU8 = 40 * MiB;
constexpr size_t WS_H8 = 104 * MiB;
constexpr size_t WS_ACT8 = 136 * MiB;
constexpr size_t WS_XN = WS_ACT8;
constexpr size_t WS_YS = 264 * MiB + 512 * KiB;
constexpr size_t WS_RS = 410 * MiB; constexpr size_t WS_YSD = 272 * MiB + 512 * KiB;
constexpr size_t WS_PROJ = WS_YS;
constexpr size_t WS_MIX = WS_XN + 64 * MiB;
constexpr size_t WS_RSTD1 = 640 * KiB;
constexpr size_t WS_X1B = WS_YS + 160 * MiB;
constexpr size_t WS_HST = WS_YS + 224 * MiB;
constexpr size_t WS_HDEC = WS_HST + 16 * MiB;
constexpr size_t WS_END = WS_YS + 256 * MiB + 512 * KiB;
constexpr float WSCALE = 64.0f, WINV = 1.0f / 64.0f;
constexpr int CW_CNT = 8192;
constexpr int CW_BAR = 0;

struct Params {
    const float *x, *norm1_g, *w_in, *hgrn_lb, *hgrn_norm_g, *pool_w, *pool_scale, *w_out, *norm2_g, *router_w, *router_b,
        *w_gate, *b_gate, *w_up, *b_up, *w_down, *b_down, *norm_f_g;
    float* out; unsigned char* ws; int ph_lo, ph_hi;
};

__device__ __forceinline__ unsigned f2bf(float f) { unsigned u = __float_as_uint(f); return (u + 0x7fffu + ((u >> 16) & 1u)) >> 16; }
__device__ __forceinline__ unsigned pk2(float lo, float hi) { unsigned r; asm("v_cvt_pk_bf16_f32 %0, %1, %2" : "=v"(r) : "v"(lo), "v"(hi)); return r; }
__device__ __forceinline__ float bf2f(unsigned b) { return __uint_as_float(b << 16); }
__device__ __forceinline__ float wave_sum(float v) {
#pragma unroll
    for (int o = 1; o < 64; o <<= 1) v += __shfl_xor(v, o);
    return v;
}
#define LDS_SYNC() do { asm volatile("s_waitcnt lgkmcnt(0)" ::: "memory"); __builtin_amdgcn_s_barrier(); asm volatile("" ::: "memory"); } while (0)
__device__ __forceinline__ float rcpf_(float x) { return __builtin_amdgcn_rcpf(x); }
__device__ __forceinline__ float rsqf_(float x) { return __builtin_amdgcn_rsqf(x); }
__device__ __forceinline__ float ex2f_(float x) { return __builtin_amdgcn_exp2f(x); }
__device__ __forceinline__ float lg2f_(float x) { return __builtin_amdgcn_logf(x); }
__device__ __forceinline__ float sigmoidf_(float z) { return rcpf_(1.0f + ex2f_(-1.4426950408889634f * z)); }
__device__ __forceinline__ unsigned pk4_fp8(float a, float b, float c, float d) { int w = __builtin_amdgcn_cvt_pk_fp8_f32(a, b, 0, false); w = __builtin_amdgcn_cvt_pk_fp8_f32(c, d, w, true); return (unsigned)w; }

#define XB_TMO      128
#define XB_XCNT(j)  (256  + 64 * (j))
#define XB_XSUB(j)  (1280 + 64 * (j))
#define XB_XGEN(j)  (2304 + 64 * (j))
#define XB_TOP      3328
#define XB_TOPGEN   3392
#define XCD_BAR_WORDS 3456
#define XB_SPIN_CAP (1u << 18)
__device__ __forceinline__ unsigned xb_ld(unsigned* p)              { return __hip_atomic_load(p, __ATOMIC_RELAXED, __HIP_MEMORY_SCOPE_AGENT); }
__device__ __forceinline__ unsigned xb_add(unsigned* p, unsigned v) { return __hip_atomic_fetch_add(p, v, __ATOMIC_RELAXED, __HIP_MEMORY_SCOPE_AGENT); }
__device__ __forceinline__ unsigned xb_xcc_id() { return (unsigned)__builtin_amdgcn_s_getreg((3 << 11) | 20) & 0xFu; }
#define XB_SPIN(cond, bar) do { unsigned _sp = 0; while (cond) { __builtin_amdgcn_s_sleep(1); \
    if ((++_sp & 255u) == 0u) { if (xb_ld(&(bar)[XB_TMO])) break; if (_sp > XB_SPIN_CAP) { atomicAdd(&(bar)[XB_TMO], 1u); break; } } } } while (0)
struct XcdBarrier { unsigned* bar; unsigned x; volatile LAS unsigned* st; };
__device__ __forceinline__ XcdBarrier xcd_barrier_post(unsigned* bar, volatile LAS unsigned* st) {
    XcdBarrier b; b.bar = bar; b.x = xb_xcc_id(); b.st = st;
    if (threadIdx.x == 0) (void)xb_add(&bar[XB_XCNT(b.x)], 1u);
    return b;
}
__device__ __forceinline__ void xcd_barrier_complete(unsigned* bar, unsigned x, unsigned& nloc, unsigned& nx) {
    const unsigned G = gridDim.x * gridDim.y * gridDim.z;
    unsigned sum, cnt, mine, sp = 0u;
    for (;;) {
        sum = 0u; cnt = 0u; mine = 0u;
#pragma unroll
        for (unsigned j = 0; j < 16; ++j) { const unsigned c = xb_ld(&bar[XB_XCNT(j)]); sum += c; cnt += (c > 0u) ? 1u : 0u; mine = (j == x) ? c : mine; }
        if (sum == G) break;
        __builtin_amdgcn_s_sleep(1);
        if ((++sp & 255u) == 0u) { if (xb_ld(&bar[XB_TMO])) break; if (sp > XB_SPIN_CAP) { atomicAdd(&bar[XB_TMO], 1u); break; } }
    }
    nloc = mine > 0u ? mine : 1u; nx = cnt > 0u ? cnt : 1u;
}
__device__ __forceinline__ void xcd_barrier(const XcdBarrier& b) {
    asm volatile("s_waitcnt vmcnt(0)" ::: "memory");
    __syncthreads();
    if (threadIdx.x == 0) {
        unsigned* bar = b.bar;
        __builtin_amdgcn_s_waitcnt(0);
        unsigned nloc = b.st[0], nx = b.st[1];
        if (nloc == 0u) { xcd_barrier_complete(bar, b.x, nloc, nx); b.st[0] = nloc; b.st[1] = nx; }
        const unsigned old = xb_add(&bar[XB_XSUB(b.x)], 1u);
        const unsigned gen = old / nloc;
        if (old + 1u == (gen + 1u) * nloc) {
            __builtin_amdgcn_fence(__ATOMIC_RELEASE, "agent");
            asm volatile("s_waitcnt vmcnt(0)" ::: "memory");
            const unsigned og = xb_add(&bar[XB_TOP], 1u);
            const unsigned tg = og / nx;
            if (og + 1u == (tg + 1u) * nx) xb_add(&bar[XB_TOPGEN], 1u);
            else XB_SPIN(xb_ld(&bar[XB_TOPGEN]) == tg, bar);
            __builtin_amdgcn_fence(__ATOMIC_ACQUIRE, "agent");
            xb_add(&bar[XB_XGEN(b.x)], 1u);
            asm volatile("s_waitcnt vmcnt(0)" ::: "memory");
        } else {
            XB_SPIN(xb_ld(&bar[XB_XGEN(b.x)]) == gen, bar);
            __builtin_amdgcn_fence(__ATOMIC_ACQUIRE, "agent");
            asm volatile("s_waitcnt vmcnt(0)" ::: "memory");
        }
    }
    __syncthreads();
}

struct Frame {
    LAS unsigned char* lds;
    int tid, lane, wave, G, bid, gw, NGW;
};

__device__ __forceinline__ void transpose_item(const float* W, int K, int N, bf16* WT, int ldt, int k0, int n0, int rowbase, LAS float* scr, int lane, const float* kscale = nullptr) {
#pragma unroll 32
    for (int i = 0; i < 32; ++i) { const int kk = 2 * i + (lane >> 5); scr[kk * 33 + (lane & 31)] = W[(size_t)(k0 + kk) * N + n0 + (lane & 31)] * (kscale ? kscale[k0 + kk] : 1.0f); }
    asm volatile("s_waitcnt lgkmcnt(0)" ::: "memory");
    const int c = lane & 7;
#pragma unroll
    for (int j = 0; j < 4; ++j) { const int n = (lane >> 3) + 8 * j; const LAS float* s = scr + (8 * c) * 33 + n;
        v4u o; o.x = pk2(s[0 * 33], s[1 * 33]); o.y = pk2(s[2 * 33], s[3 * 33]); o.z = pk2(s[4 * 33], s[5 * 33]); o.w = pk2(s[6 * 33], s[7 * 33]);
        *(v4u*)(WT + (size_t)(rowbase + n) * ldt + k0 + 8 * c) = o; }
    asm volatile("s_waitcnt lgkmcnt(0)" ::: "memory");
}

constexpr int CV_WGU = 2 * NE * 256, CV_WD = NE * 256, CV_WD_A = CV_WD / 2, CV_PITCH = 144, CV_LDS = 32 * CV_PITCH;
struct CvItem { const float* src; unsigned char* dst; };
__device__ __forceinline__ unsigned perm_b32(unsigned hi, unsigned lo, unsigned sel) { return __builtin_amdgcn_perm(hi, lo, sel); }
__device__ __forceinline__ CvItem cv_addr(const Params& p, int mat, int r, int lane) {
    const int e = r >> 8, kg = (r >> 5) & 7, ng = r & 31, k0 = 128 * kg, n0 = 32 * ng;
    const float* W = (mat == 0 ? p.w_gate : mat == 1 ? p.w_up : p.w_down) + (size_t)e * D * FF;
    CvItem c; c.src = W + (size_t)(k0 + 4 * (lane >> 3)) * FF + n0 + 4 * (lane & 7);
    if (mat == 2) c.dst = p.ws + WS_WD8 + ((size_t)e * D + n0) * FF + k0;
    else c.dst = p.ws + WS_WGU8 + ((size_t)e * 2048 + (n0 >> 7) * 256 + (mat == 1 ? 128 : 0) + (n0 & 127)) * D + k0;
    return c;
}
__device__ __forceinline__ void cv_load(const CvItem& c, f32x4 (&v)[16]) {
#pragma unroll
    for (int jj = 0; jj < 16; ++jj) v[jj] = *(const f32x4*)(c.src + (size_t)(32 * (jj >> 2) + (jj & 3)) * FF);
}
__device__ __forceinline__ void cv_store(const CvItem& c, const f32x4 (&v)[16], LAS unsigned char* scr, int lane) {
    const int g = lane >> 3, cq = lane & 7;
#pragma unroll
    for (int a = 0; a < 4; ++a) { unsigned d[4];
#pragma unroll
        for (int b = 0; b < 4; ++b) { const f32x4 x = v[4 * a + b] * WSCALE; d[b] = pk4_fp8(x[0], x[1], x[2], x[3]); }
        const unsigned x0 = perm_b32(d[1], d[0], 0x05010400u), x1 = perm_b32(d[1], d[0], 0x07030602u), y0 = perm_b32(d[3], d[2], 0x05010400u), y1 = perm_b32(d[3], d[2], 0x07030602u);
        LAS unsigned char* q = scr + (4 * cq) * CV_PITCH + 32 * a + 4 * g;
        *(LAS unsigned*)(q) = perm_b32(y0, x0, 0x05040100u); *(LAS unsigned*)(q + CV_PITCH) = perm_b32(y0, x0, 0x07060302u);
        *(LAS unsigned*)(q + 2 * CV_PITCH) = perm_b32(y1, x1, 0x05040100u); *(LAS unsigned*)(q + 3 * CV_PITCH) = perm_b32(y1, x1, 0x07060302u); }
    asm volatile("s_waitcnt lgkmcnt(0)" ::: "memory");
#pragma unroll
    for (int i = 0; i < 4; ++i) { const int row = (lane >> 3) + 8 * i, ch = lane & 7; const v4u w = *(const LAS v4u*)(scr + row * CV_PITCH + 16 * ch); *(v4u*)(c.dst + (size_t)row * D + 16 * ch) = w; }
    asm volatile("s_waitcnt lgkmcnt(0)" ::: "memory");
}
struct CvJob {
    int mat0, item, stride, limit; bool live; CvItem c; f32x4 v[16];
    __device__ __forceinline__ void init(int mat0_, int first, int stride_, int limit_) { mat0 = mat0_; item = first; stride = stride_; limit = limit_; live = false; }
    __device__ __forceinline__ void top(const Params& p, int lane) { live = item < limit; const int it = live ? item : 0;
        c = cv_addr(p, mat0 + it / (NE * 256), it % (NE * 256), lane); cv_load(c, v); }
    __device__ __forceinline__ void bottom(LAS unsigned char* scr, int lane) {
        if (live) {
#pragma unroll
            for (int jj = 0; jj < 16; ++jj) asm volatile("" : "+v"(v[jj]));
            cv_store(c, v, scr, lane); item += stride; live = false; }
    }
    __device__ __forceinline__ void rest(const Params& p, LAS unsigned char* scr, int lane) { run(p, scr, lane, 0x7fffffff / 2); }
    __device__ __forceinline__ void run(const Params& p, LAS unsigned char* scr, int lane, int n) {
        if (n > (limit - item + stride - 1) / stride) n = (limit - item + stride - 1) / stride;
        if (n <= 0) return;
        f32x4 vb[16]; CvItem c0 = addr_of(p, item, lane), c1;
        cv_load(c0, v);
        for (int k = 0; k < n; k += 2) {
            c1 = addr_of(p, item + ((k + 1 < n) ? stride : 0), lane); cv_load(c1, vb);
#pragma unroll
            for (int jj = 0; jj < 16; ++jj) asm volatile("" : "+v"(v[jj]));
            cv_store(c0, v, scr, lane); item += stride;
            if (k + 1 >= n) break;
            c0 = addr_of(p, item + ((k + 2 < n) ? stride : 0), lane); cv_load(c0, v);
#pragma unroll
            for (int jj = 0; jj < 16; ++jj) asm volatile("" : "+v"(vb[jj]));
            cv_store(c1, vb, scr, lane); item += stride;
        }
    }
    __device__ __forceinline__ CvItem addr_of(const Params& p, int it, int lane) const { return cv_addr(p, mat0 + it / (NE * 256), it % (NE * 256), lane); }
};

__device__ __forceinline__ void phase_prep(const Params& p, Frame& F) {
    LAS float* scr = (LAS float*)(F.lds + F.wave * 16896);
    bf16* WINT = (bf16*)(p.ws + WS_WINT); bf16* WOUTT = (bf16*)(p.ws + WS_WOUTT);
    bf16* POOLT = (bf16*)(p.ws + WS_POOLT); bf16* XN = (bf16*)(p.ws + WS_XN);
    constexpr int I_IN = (D / 64) * (INC / 32), I_OUT = (D / 64) * (D / 32), I_POOL = 4 * (128 / 64) * (128 / 32);
    constexpr int NITEMS = I_IN + I_OUT + I_POOL;
    for (int it = F.gw; it < NITEMS; it += F.NGW) {
        int r = it;
        if (r < I_IN) { const int nb = INC / 32; transpose_item(p.w_in, D, INC, WINT, D, 64 * (r / nb), 32 * (r % nb), 32 * (r % nb), scr, F.lane, p.norm1_g); continue; } r -= I_IN;
        if (r < I_OUT) { const int nb = D / 32; transpose_item(p.w_out, D, D, WOUTT, D, 64 * (r / nb), 32 * (r % nb), 32 * (r % nb), scr, F.lane); continue; } r -= I_OUT;
        { const int g = r / 8, q = r % 8; transpose_item(p.pool_w + (size_t)g * 128 * 128, 128, 128, POOLT + (size_t)g * 128 * 128, 128, 64 * (q / 4), 32 * (q % 4), 32 * (q % 4), scr, F.lane); }
    }
    { bf16* WRH = (bf16*)(p.ws + WS_WRH); bf16* WRL = (bf16*)(p.ws + WS_WRL);
      for (int i = F.bid * NTHREADS + F.tid; i < NE * D; i += F.G * NTHREADS) { const int e = i / D, k = i % D; const float wv = p.norm2_g[k] * p.router_w[k * NE + e]; const unsigned h = f2bf(wv); WRH[i] = (bf16)h; WRL[i] = (bf16)f2bf(wv - bf2f(h)); } }
    float* RSTD1 = (float*)(p.ws + WS_RSTD1);
    for (int m = 2 * F.gw; m < NTOK; m += 2 * F.NGW) {
        f32x4 v[2][4];
#pragma unroll
        for (int r = 0; r < 2; ++r)
#pragma unroll
            for (int j = 0; j < 4; ++j) v[r][j] = ((const f32x4*)(p.x + (size_t)(m + r) * D) + F.lane)[64 * j];
#pragma unroll
        for (int r = 0; r < 2; ++r) { float s = 0.f;
#pragma unroll
            for (int j = 0; j < 4; ++j) s += (v[r][j].x * v[r][j].x + v[r][j].y * v[r][j].y) + (v[r][j].z * v[r][j].z + v[r][j].w * v[r][j].w);
            const float rstd = rsqf_(wave_sum(s) * (1.0f / D) + EPS);
            if (F.lane == 0) RSTD1[m + r] = rstd;
            v2u* o8 = (v2u*)(XN + (size_t)(m + r) * D) + F.lane;
#pragma unroll
            for (int j = 0; j < 4; ++j) { v2u w; w.x = pk2(v[r][j].x, v[r][j].y); w.y = pk2(v[r][j].z, v[r][j].w); o8[64 * j] = w; } }
    }
}

__device__ __forceinline__ void load_tables(const Params& p, Frame& F, LAS int* sb);
typedef float hg2 __attribute__((ext_vector_type(2)));
__device__ __forceinline__ void phase_final(const Params& p, Frame& F) {
    const unsigned char* YS = p.ws + WS_YSD; const bf16* X1B = (const bf16*)(p.ws + WS_X1B);
    const int* TOKES = (const int*)(p.ws + WS_TOKES); const float* TOKG = (const float*)(p.ws + WS_TOKGATE);
    LAS int* sb = (LAS int*)(F.lds + LDS_TAB); if (p.ph_lo > 6) load_tables(p, F, sb);
    f32x4 gv[4];
#pragma unroll
    for (int j = 0; j < 4; ++j) gv[j] = ((const f32x4*)p.norm_f_g + F.lane)[64 * j];
#pragma unroll
    for (int j = 0; j < 4; ++j) asm volatile("" : "+v"(gv[j]));
    for (int m0 = 4 * F.gw; m0 < NTOK; m0 += 4 * F.NGW) {
        f32x4 v[4][4]; int es[4][4]; float gt[4][4];
#pragma unroll
        for (int r = 0; r < 4; ++r) {
#pragma unroll
            for (int k = 0; k < 4; ++k) { es[r][k] = TOKES[(m0 + r) * 4 + k]; gt[r][k] = TOKG[(m0 + r) * 4 + k]; }
#pragma unroll
            for (int j = 0; j < 4; ++j) { const v2u xw = ((const v2u*)(X1B + (size_t)(m0 + r) * D) + F.lane)[64 * j];
                v[r][j] = (f32x4){__uint_as_float(xw.x << 16), __uint_as_float(xw.x & 0xffff0000u), __uint_as_float(xw.y << 16), __uint_as_float(xw.y & 0xffff0000u)}; } }
#pragma unroll
        for (int r = 0; r < 4; ++r)
#pragma unroll
            for (int k = 0; k < 4; ++k) { const int slot = es[r][k] & 0xffff, tile = sb[64 + (es[r][k] >> 16)] + (slot >> 8); const float g = gt[r][k];
                const unsigned* s4 = (const unsigned*)(YS + (size_t)tile * 262144 + ((slot & 255) >> 2) * 4096 + (slot & 3) * 256) + F.lane;
                unsigned w[4];
#pragma unroll
                for (int j = 0; j < 4; ++j) w[j] = s4[256 * j];
#pragma unroll
                for (int j = 0; j < 4; ++j) { const hg2 lo = __builtin_amdgcn_cvt_pk_f32_fp8((int)w[j], false), hi = __builtin_amdgcn_cvt_pk_f32_fp8((int)w[j], true);
                    v[r][j].x += g * lo.x; v[r][j].y += g * lo.y; v[r][j].z += g * hi.x; v[r][j].w += g * hi.y; } }
#pragma unroll
        for (int r = 0; r < 4; ++r) { float s = 0.f;
#pragma unroll
            for (int j = 0; j < 4; ++j) s += (v[r][j].x * v[r][j].x + v[r][j].y * v[r][j].y) + (v[r][j].z * v[r][j].z + v[r][j].w * v[r][j].w);
            const float rstd = rsqf_(wave_sum(s) * (1.0f / D) + EPS);
            f32x4* xr = (f32x4*)(p.out + (size_t)(m0 + r) * D) + F.lane;
#pragma unroll
            for (int j = 0; j < 4; ++j) { const f32x4 g = gv[j]; f32x4 o; o.x = v[r][j].x * rstd * g.x; o.y = v[r][j].y * rstd * g.y; o.z = v[r][j].z * rstd * g.z; o.w = v[r][j].w * rstd * g.w; xr[64 * j] = o; } }
    }
}

namespace gg {
constexpr int BM = 256, BK = 64, HALF = 128, HTB = HALF * BK * 2, STAGE_BYTES = 8 * HTB, NXCD = 8, WGM = 8;
typedef int i32x4 __attribute__((ext_vector_type(4)));
typedef int i32x8 __attribute__((ext_vector_type(8)));
__device__ __forceinline__ int lds_byte(int r, int c) { const int st = (r >> 4) * 2 + (c >> 5), rr = r & 15, cc = c & 31, ob = rr * 64 + cc * 2; return st * 1024 + (ob ^ (((ob >> 9) & 1) << 5)); }
__device__ __forceinline__ void stage_rc(int b, int& R, int& C) { const int st = b / 1024, sb = b % 1024, swz = sb ^ (((sb >> 9) & 1) << 5); R = (st >> 1) * 16 + swz / 64; C = (st & 1) * 32 + (swz % 64) / 2; }
__device__ __forceinline__ int perm32(int rho) { const int n = rho >> 4, i = rho & 15; return 8 * (i >> 2) + 4 * n + (i & 3); }
__device__ __forceinline__ unsigned cvt_pk_bf16(float lo, float hi) { unsigned r; asm volatile("v_cvt_pk_bf16_f32 %0, %1, %2" : "=v"(r) : "v"(lo), "v"(hi)); return r; }

struct Unit { const char* B; unsigned char* dst; int row0, nvalid, pn, e, r0, cnt, tile; };

template <class Sched, class Epi>
__device__ __forceinline__ void gemm_phase(LAS unsigned char* lds, const Sched& S, const Epi& E) {
    const int tid = threadIdx.x, wid = __builtin_amdgcn_readfirstlane(tid >> 6), lane = tid & 63, wr = wid >> 2, wc = wid & 3, fr = lane & 15, fq = lane >> 4;
    constexpr int KB = Sched::KB, nt = KB / 128; constexpr bool F8 = Sched::F8;
    int R[2], C[2]; unsigned voffB[2];
#pragma unroll
    for (int i = 0; i < 2; ++i) { stage_rc(tid * 16 + i * 8192, R[i], C[i]); const int Rb = Epi::PERM ? ((R[i] & ~31) + perm32(R[i] & 31)) : R[i]; voffB[i] = (unsigned)(Rb * KB + C[i] * 2); }
    const size_t kstep = (size_t)(BK * 2), akstep = (size_t)Sched::AKSTEP;
    const size_t hstep = (size_t)HALF * KB;
    const unsigned ldsw = (unsigned)wid * 1024u;
    const int aoff = lds_byte(wr * 64 + fr, fq * 8), boff = lds_byte(wc * 32 + fr, fq * 8);
    const char* const Abase = S.abase();
#define PG8_SA(b, h) (((b) * 2 + (h)) * HTB)
#define PG8_SB(b, h) ((4 + (b) * 2 + (h)) * HTB)
#define PG8_STAGE(bufoff, gbase, voff) do { _Pragma("unroll") for (int _i = 0; _i < 2; ++_i) \
        __builtin_amdgcn_global_load_lds((const unsigned*)((const char*)(gbase) + (voff)[_i]), (LAS unsigned*)(lds + (bufoff) + ldsw + _i * 8192), 16, 0, 0); } while (0)
#define PG8_RD(off) (*(const LAS i32x4*)(lds + (off)))
#define PG8_LDA(dst, b, h) do { _Pragma("unroll") for (int m = 0; m < 4; ++m) { if constexpr (F8) dst##8[m] = __builtin_shufflevector(PG8_RD(PG8_SA(b, h) + aoff + m * 2048), PG8_RD(PG8_SA(b, h) + aoff + m * 2048 + 1024), 0, 1, 2, 3, 4, 5, 6, 7); \
        else { _Pragma("unroll") for (int k = 0; k < 2; ++k) dst[m][k] = *(const LAS bf16x8*)(lds + PG8_SA(b, h) + aoff + m * 2048 + k * 1024); } } } while (0)
#define PG8_LDB(dst, b, h) do { _Pragma("unroll") for (int n = 0; n < 2; ++n) { if constexpr (F8) dst##8[n] = __builtin_shufflevector(PG8_RD(PG8_SB(b, h) + boff + n * 2048), PG8_RD(PG8_SB(b, h) + boff + n * 2048 + 1024), 0, 1, 2, 3, 4, 5, 6, 7); \
        else { _Pragma("unroll") for (int k = 0; k < 2; ++k) dst[n][k] = *(const LAS bf16x8*)(lds + PG8_SB(b, h) + boff + n * 2048 + k * 1024); } } } while (0)
#define PG8_MMA(ai, bj, At, Bt) do { __builtin_amdgcn_s_setprio(1); _Pragma("unroll") for (int m = 0; m < 4; ++m) _Pragma("unroll") for (int n = 0; n < 2; ++n) { \
        if constexpr (F8) asm volatile("v_mfma_f32_16x16x128_f8f6f4 %0, %1, %2, %0" : "+v"(acc[ai][bj][m][n]) : "v"(Bt##8[n]), "v"(At##8[m]));     \
        else { _Pragma("unroll") for (int k = 0; k < 2; ++k) acc[ai][bj][m][n] = __builtin_amdgcn_mfma_f32_16x16x32_bf16(Bt[n][k], At[m][k], acc[ai][bj][m][n], 0, 0, 0); } } \
        __builtin_amdgcn_s_setprio(0); } while (0)
#define PG8_WAIT_V(n) asm volatile("s_waitcnt vmcnt(" #n ")" ::: "memory")
#define PG8_WAIT_L(n) asm volatile("s_waitcnt lgkmcnt(" #n ")" ::: "memory")
#define PG8_WAIT_VX(first) do { if (EX > 0 && (first)) asm volatile("s_waitcnt vmcnt(%0)" :: "n"(8 + EX) : "memory"); else PG8_WAIT_V(8); } while (0)
#define PG8_BAR __builtin_amdgcn_s_barrier()
#define PG8_SCHED __builtin_amdgcn_sched_barrier(0)
    constexpr int EX = Epi::NVM > 0 ? Epi::NVM + (Epi::BIAS_LDS ? 1 : 0) + Sched::NIDX : 0;
    Unit cur, nxt; int ui = 0; bool relax = false;
    if (!S.next(0, cur)) return;
    bool has_next = S.next(1, nxt);
    unsigned ao[2][2], nao[2][2];
    { int t0[2][2] = {{0, 0}, {0, 0}}, t1[2][2] = {{0, 0}, {0, 0}}; S.aload(cur, R, C, t0); if (has_next) S.aload(nxt, R, C, t1); S.afin(cur, R, C, t0, ao);
      if (has_next) S.afin(nxt, R, C, t1, nao); else { nao[0][0] = ao[0][0]; nao[0][1] = ao[0][1]; nao[1][0] = ao[1][0]; nao[1][1] = ao[1][1]; } }
    asm volatile("" : "+v"(ao[0][0]), "+v"(ao[0][1]), "+v"(ao[1][0]), "+v"(ao[1][1]));
    asm volatile("" : "+v"(nao[0][0]), "+v"(nao[0][1]), "+v"(nao[1][0]), "+v"(nao[1][1]));
    f32x4 acc[2][2][4][2];
#pragma unroll
    for (int a = 0; a < 2; ++a)
#pragma unroll
        for (int b = 0; b < 2; ++b)
#pragma unroll
            for (int m = 0; m < 4; ++m)
#pragma unroll
                for (int n = 0; n < 2; ++n) acc[a][b][m][n] = (f32x4){0.f, 0.f, 0.f, 0.f};
    bf16x8 At[4][2], B0[2][2], B1[2][2]; i32x8 At8[4], B08[2], B18[2];
    const char* cB = cur.B;
    PG8_STAGE(PG8_SB(0, 0), cB, voffB); PG8_STAGE(PG8_SB(0, 1), cB + hstep, voffB); PG8_STAGE(PG8_SA(0, 0), Abase, ao[0]); PG8_STAGE(PG8_SA(0, 1), Abase, ao[1]);
    if (wr == 1) PG8_BAR;
    PG8_WAIT_V(2); PG8_BAR;
    PG8_STAGE(PG8_SB(1, 0), cB + kstep, voffB); PG8_STAGE(PG8_SA(1, 0), Abase + akstep, ao[0]); PG8_STAGE(PG8_SB(1, 1), cB + hstep + kstep, voffB);
    PG8_WAIT_V(6); PG8_BAR;
    for (;;) {
        const char* nB = has_next ? nxt.B : cB;
        if constexpr (Epi::BIAS_LDS) {
            const float* bsrc = E.bias_src(cur, lane);
            __builtin_amdgcn_global_load_lds((const unsigned*)bsrc, (LAS unsigned*)(lds + LDS_BIAS + wid * 1024), 16, 0, 0);
        }
        if constexpr (Epi::RS_LDS) { if (wid == 0) __builtin_amdgcn_global_load_lds((const unsigned*)E.rs_src(cur, lane), (LAS unsigned*)(lds + LDS_RS), 16, 0, 0); }
#pragma unroll 1
        for (int t = 0; t < nt; t += 2) {
            const bool last = (t == nt - 2);
            const char* a1 = Abase + (size_t)(t + 1) * akstep;
            const char* a2 = last ? Abase : Abase + (size_t)(t + 2) * akstep; const char* b2 = last ? nB : cB + (size_t)(t + 2) * kstep;
            const char* a3 = a2 + akstep; const char* b3 = b2 + kstep;
            unsigned s2[2][2];
#pragma unroll
            for (int h = 0; h < 2; ++h)
#pragma unroll
                for (int i = 0; i < 2; ++i) s2[h][i] = last ? nao[h][i] : ao[h][i];
            const bool first = relax && t == 0;
            PG8_LDB(B0, 0, 0); PG8_LDB(B1, 0, 1); PG8_SCHED; PG8_LDA(At, 0, 0); PG8_STAGE(PG8_SA(1, 1), a1, ao[1]);
            PG8_WAIT_VX(first); PG8_WAIT_L(0); PG8_BAR; PG8_MMA(0, 0, At, B0); PG8_MMA(0, 1, At, B1); PG8_BAR; PG8_SCHED;
            PG8_LDA(At, 0, 1); PG8_STAGE(PG8_SB(0, 0), b2, voffB); PG8_STAGE(PG8_SB(0, 1), b2 + hstep, voffB); PG8_STAGE(PG8_SA(0, 0), a2, s2[0]);
            PG8_WAIT_VX(first); PG8_WAIT_L(0); PG8_BAR; PG8_MMA(1, 0, At, B0); PG8_MMA(1, 1, At, B1); PG8_BAR; PG8_SCHED;
            PG8_LDB(B0, 1, 0); PG8_LDB(B1, 1, 1); PG8_SCHED; PG8_LDA(At, 1, 0); PG8_STAGE(PG8_SA(0, 1), a2, s2[1]);
            PG8_WAIT_V(8); PG8_WAIT_L(0); PG8_BAR; PG8_MMA(0, 0, At, B0); PG8_MMA(0, 1, At, B1); PG8_BAR; PG8_SCHED;
            PG8_LDA(At, 1, 1); PG8_STAGE(PG8_SB(1, 0), b3, voffB); PG8_STAGE(PG8_SB(1, 1), b3 + hstep, voffB); PG8_STAGE(PG8_SA(1, 0), a3, s2[0]);
            PG8_WAIT_V(8); PG8_WAIT_L(0); PG8_BAR; PG8_MMA(1, 0, At, B0); PG8_MMA(1, 1, At, B1); PG8_BAR; PG8_SCHED;
        }
        if (wr == 0) PG8_BAR;
        Unit nn; bool hn2 = false; int tk[2][2] = {{0, 0}, {0, 0}};
        if (has_next) { hn2 = S.next(ui + 2, nn); S.aload(hn2 ? nn : nxt, R, C, tk); }
        asm volatile("" ::: "memory");
        if constexpr (F8) asm volatile("s_nop 15\n\ts_nop 15" ::: "memory");
        { int fr_e = fr, fq_e = fq; asm volatile("" : "+v"(fr_e), "+v"(fq_e)); E(acc, cur, wr, wc, fr_e, fq_e); }
        if (!has_next) break;
#pragma unroll
        for (int a = 0; a < 2; ++a)
#pragma unroll
            for (int b = 0; b < 2; ++b)
#pragma unroll
                for (int m = 0; m < 4; ++m)
#pragma unroll
                    for (int n = 0; n < 2; ++n) acc[a][b][m][n] = (f32x4){0.f, 0.f, 0.f, 0.f};
        cur = nxt; cB = nB; ++ui; relax = true;
#pragma unroll
        for (int h = 0; h < 2; ++h)
#pragma unroll
            for (int i = 0; i < 2; ++i) ao[h][i] = nao[h][i];
        has_next = hn2;
        asm volatile("" : "+v"(tk[0][0]), "+v"(tk[0][1]), "+v"(tk[1][0]), "+v"(tk[1][1]));
        if (has_next) { nxt = nn; S.afin(nxt, R, C, tk, nao); asm volatile("" : "+v"(nao[0][0]), "+v"(nao[0][1]), "+v"(nao[1][0]), "+v"(nao[1][1])); }
        if (wr == 1) PG8_BAR;
    }
    PG8_WAIT_V(0);
    PG8_BAR;
#undef PG8_SA
#undef PG8_SB
#undef PG8_STAGE
#undef PG8_LDA
#undef PG8_RD
#undef PG8_LDB
#undef PG8_MMA
#undef PG8_WAIT_V
#undef PG8_WAIT_VX
#undef PG8_WAIT_L
#undef PG8_BAR
#undef PG8_SCHED
}

struct DenseSched {
    static constexpr int KB = 2048; static constexpr bool F8 = false; static constexpr int NIDX = 0; static constexpr int AKSTEP = 128;
    const char* A; const char* Bt; int nM, nN, nwg, G, c;
    __device__ __forceinline__ void init(const void* A_, const void* Bt_, int M, int N, int G_, int c_) { A = (const char*)A_; Bt = (const char*)Bt_; nM = M / BM; nN = N / BM; nwg = nM * nN; G = G_; c = c_; }
    __device__ __forceinline__ const char* abase() const { return A; }
    __device__ __forceinline__ bool next(int i, Unit& u) const {
        const long L = (long)i * G + c; if (L >= nwg) return false;
        int wgid = (int)L; { const int q = nwg / NXCD, r = nwg % NXCD, xcd = wgid % NXCD, off = wgid / NXCD; wgid = (xcd < r ? xcd * (q + 1) : r * (q + 1) + (xcd - r) * q) + off; }
        const int nig = WGM * nN, gid = wgid / nig, fm = gid * WGM, gsz = (nM - fm) < WGM ? (nM - fm) : WGM;
        const int pm = fm + ((wgid % nig) % gsz), pn = (wgid % nig) / gsz;
        u.B = Bt + (size_t)pn * BM * KB; u.dst = nullptr; u.row0 = pm * BM; u.nvalid = BM; u.pn = pn; u.e = 0; u.r0 = 0; u.cnt = 0; u.tile = 0; return true;
    }
    __device__ __forceinline__ void aload(const Unit&, const int (&)[2], const int (&)[2], int (&)[2][2]) const {}
    __device__ __forceinline__ void afin(const Unit& u, const int (&R)[2], const int (&C)[2], const int (&)[2][2], unsigned (&o)[2][2]) const {
#pragma unroll
        for (int h = 0; h < 2; ++h)
#pragma unroll
            for (int i = 0; i < 2; ++i) o[h][i] = (unsigned)((u.row0 + h * HALF + R[i]) * KB + C[i] * 2);
    }
};
}

struct EpiProj {
    static constexpr bool PERM = true, BIAS_LDS = false, RS_LDS = false; static constexpr int NVM = 0;
    bf16* O; const float* rstd;
    __device__ __forceinline__ void operator()(const f32x4 (&acc)[2][2][4][2], const gg::Unit& u, int wr, int wc, int fr, int fq) const {
        const int row0 = u.row0 + wr * 64 + fr, col0 = u.pn * 256 + wc * 32 + 8 * fq;
#pragma unroll
        for (int ai = 0; ai < 2; ++ai)
#pragma unroll
            for (int m = 0; m < 4; ++m) { bf16* rowp = O + (size_t)(row0 + ai * 128 + m * 16) * INC + col0; const float rs = rstd[row0 + ai * 128 + m * 16];
#pragma unroll
                for (int bj = 0; bj < 2; ++bj) { const f32x4 v0 = acc[ai][bj][m][0] * rs, v1 = acc[ai][bj][m][1] * rs;
                    v4u w; w.x = gg::cvt_pk_bf16(v0[0], v0[1]); w.y = gg::cvt_pk_bf16(v0[2], v0[3]); w.z = gg::cvt_pk_bf16(v1[0], v1[1]); w.w = gg::cvt_pk_bf16(v1[2], v1[3]);
                    *(v4u*)(rowp + bj * 128) = w; } }
    }
};
struct EpiX1 {
    static constexpr bool PERM = true, BIAS_LDS = false, RS_LDS = false; static constexpr int NVM = 0;
    const bf16* X; bf16* O;
    __device__ __forceinline__ void operator()(const f32x4 (&acc)[2][2][4][2], const gg::Unit& u, int wr, int wc, int fr, int fq) const {
        const int row0 = u.row0 + wr * 64 + fr, col0 = u.pn * 256 + wc * 32 + 8 * fq;
#pragma unroll
        for (int ai = 0; ai < 2; ++ai)
#pragma unroll
            for (int m = 0; m < 4; ++m) { const size_t off = (size_t)(row0 + ai * 128 + m * 16) * D + col0;
#pragma unroll
                for (int bj = 0; bj < 2; ++bj) { const v4u xw = *(const v4u*)(X + off + bj * 128);
                    const f32x4 v0 = acc[ai][bj][m][0] + (f32x4){__uint_as_float(xw.x << 16), __uint_as_float(xw.x & 0xffff0000u), __uint_as_float(xw.y << 16), __uint_as_float(xw.y & 0xffff0000u)};
                    const f32x4 v1 = acc[ai][bj][m][1] + (f32x4){__uint_as_float(xw.z << 16), __uint_as_float(xw.z & 0xffff0000u), __uint_as_float(xw.w << 16), __uint_as_float(xw.w & 0xffff0000u)};
                    v4u w; w.x = pk2(v0[0], v0[1]); w.y = pk2(v0[2], v0[3]); w.z = pk2(v1[0], v1[1]); w.w = pk2(v1[2], v1[3]);
                    *(v4u*)(O + off + bj * 128) = w; } }
    }
};

__device__ __forceinline__ void staggered_conv(const Params& p, Frame& F, CvJob& cv, int n) { if (n > 0) { cv.run(p, F.lds + F.wave * CV_LDS, F.lane, n); } __syncthreads(); }
__device__ __forceinline__ void phase_inproj(const Params& p, Frame& F) {
    const int g = (F.bid >> 3) & 3; const int per = (CV_WGU + F.NGW - 1) / F.NGW;
    const int pre = (per * g + 1) / 3;
    CvJob cv; cv.init(0, F.gw, F.NGW, CV_WGU);
    staggered_conv(p, F, cv, pre);
    gg::DenseSched S; S.init(p.ws + WS_XN, p.ws + WS_WINT, NTOK, INC, F.G, F.bid);
    EpiProj E{(bf16*)(p.ws + WS_PROJ), (const float*)(p.ws + WS_RSTD1)};
    gg::gemm_phase<gg::DenseSched, EpiProj>(F.lds, S, E);
    __syncthreads();
    cv.rest(p, F.lds + F.wave * CV_LDS, F.lane);
}
__device__ __forceinline__ void phase_outproj(const Params& p, Frame& F) {
    const int g = (F.bid >> 3) & 3; const int per = (CV_WD_A + F.NGW - 1) / F.NGW;
    const int pre = (per * g + 1) / 3;
    CvJob cv; cv.init(2, F.gw, F.NGW, CV_WD_A);
    staggered_conv(p, F, cv, pre);
    gg::DenseSched S; S.init(p.ws + WS_MIX, p.ws + WS_WOUTT, NTOK, D, F.G, F.bid);
    EpiX1 E{(const bf16*)(p.ws + WS_XN), (bf16*)(p.ws + WS_X1B)};
    gg::gemm_phase<gg::DenseSched, EpiX1>(F.lds, S, E);
    __syncthreads();
    cv.rest(p, F.lds + F.wave * CV_LDS, F.lane);
}

__device__ __forceinline__ void load_tables(const Params& p, Frame& F, LAS int* sb) {
    unsigned* ctl = (unsigned*)(p.ws + WS_CTL);
    __syncthreads();
    if (F.tid < NE) sb[700 + F.tid] = (int)__hip_atomic_load(ctl + CW_CNT + 64 * F.tid, __ATOMIC_RELAXED, __HIP_MEMORY_SCOPE_AGENT);
    __syncthreads();
    if (F.tid == 0) {
        int acc = 0, tacc = 0;
        for (int e = 0; e < NE; ++e) { const int c = sb[700 + e]; sb[e] = acc; sb[64 + e] = tacc; acc += c; tacc += (c + 255) / 256; }
        sb[NE] = acc; sb[64 + NE] = tacc;
    }
    __syncthreads();
    { const int ntile = sb[64 + NE]; for (int t = F.tid; t < ntile; t += NTHREADS) { int e = 0;
#pragma unroll
        for (int st = 16; st > 0; st >>= 1) if (sb[64 + e + st] <= t) e += st;
        sb[128 + t] = e; } }
    __syncthreads();
}
__device__ __forceinline__ int lds_s(LAS const int* q) { return __builtin_amdgcn_readfirstlane(*q); }

template <int NCT, bool GATHER> struct MoeSched {
    static constexpr int KB = 1024; static constexpr bool F8 = true; static constexpr int NIDX = GATHER ? 4 : 0; static constexpr int AKSTEP = GATHER ? 128 : 256 * 128;
    const char* A; const char* W; const int* list; LAS const int* sb; int T, TPX, PX, x, j; unsigned char* dstbase; int dpitch;
    __device__ __forceinline__ void init(LAS const int* sb_, const Frame& F) { sb = sb_; T = lds_s(sb + 64 + NE); const int nx = (F.G % 8 == 0) ? 8 : 1; PX = F.G / nx; TPX = (T + nx - 1) / nx;
        const int c = (nx == 8) ? (F.bid % 8) * PX + F.bid / 8 : F.bid; x = c / PX; j = c % PX; }
    __device__ __forceinline__ int rounds() const { return (TPX * NCT + PX - 1) / PX; }
    __device__ __forceinline__ int rem() const { return (TPX * NCT) % PX; }
    __device__ __forceinline__ const char* abase() const { return A; }
    __device__ __forceinline__ bool next(int i, gg::Unit& u) const {
        const int m = i * PX + j, tl = m / NCT, ct = m % NCT, t = x * TPX + tl; if (tl >= TPX || t >= T) return false;
        const int e = lds_s(sb + 128 + t);
        const int base = lds_s(sb + e), cnt = lds_s(sb + e + 1) - base, r0 = (t - lds_s(sb + 64 + e)) * 256;
        u.B = W + (size_t)(e * NCT + ct) * 256 * KB; u.pn = ct; u.e = e; u.r0 = r0; u.cnt = cnt; u.row0 = base + r0; u.nvalid = (cnt - r0) < 256 ? (cnt - r0) : 256;
        u.tile = t; u.dst = dstbase + (size_t)(t * NCT + ct) * 256 * (1024 / NCT);
        return true;
    }
    __device__ __forceinline__ void aload(const gg::Unit& u, const int (&R)[2], const int (&C)[2], int (&tk)[2][2]) const {
        if (GATHER) {
#pragma unroll
            for (int h = 0; h < 2; ++h)
#pragma unroll
                for (int i = 0; i < 2; ++i) { int r = u.r0 + h * 128 + R[i]; if (r >= u.cnt) r = 0; tk[h][i] = list[u.e * NTOK + r]; }
        }
    }
    __device__ __forceinline__ void afin(const gg::Unit& u, const int (&R)[2], const int (&C)[2], const int (&tk)[2][2], unsigned (&o)[2][2]) const {
#pragma unroll
        for (int h = 0; h < 2; ++h)
#pragma unroll
            for (int i = 0; i < 2; ++i) {
                if (GATHER) o[h][i] = (unsigned)(tk[h][i] * KB + C[i] * 2);
                else o[h][i] = (unsigned)(((u.tile * 8) * 256 + h * 128 + R[i]) * 128 + C[i] * 2);
            }
    }
};
#define EPI_LDS_SYNC() do { asm volatile("s_waitcnt lgkmcnt(0)" ::: "memory"); __builtin_amdgcn_s_barrier(); asm volatile("" ::: "memory"); } while (0)
__device__ __forceinline__ unsigned lds_u32(const LAS void* q) { return (unsigned)(unsigned long)q; }
__device__ __forceinline__ void lds_read_bias4(const LAS float* bs, f32x4& a0, f32x4& a1, f32x4& b0, f32x4& b1) {
    asm volatile("ds_read_b128 %0, %4\n\tds_read_b128 %1, %4 offset:16\n\tds_read_b128 %2, %4 offset:512\n\tds_read_b128 %3, %4 offset:528\n\ts_waitcnt lgkmcnt(0)"
                 : "=&v"(a0), "=&v"(a1), "=&v"(b0), "=&v"(b1) : "v"(lds_u32(bs)) : "memory");
}
__device__ __forceinline__ void lds_read_rs8(const LAS float* q, float (&r)[2][4]) {
    asm volatile("ds_read_b32 %0, %8\n\tds_read_b32 %1, %8 offset:64\n\tds_read_b32 %2, %8 offset:128\n\tds_read_b32 %3, %8 offset:192\n\t"
                 "ds_read_b32 %4, %8 offset:512\n\tds_read_b32 %5, %8 offset:576\n\tds_read_b32 %6, %8 offset:640\n\tds_read_b32 %7, %8 offset:704\n\ts_waitcnt lgkmcnt(0)"
                 : "=&v"(r[0][0]), "=&v"(r[0][1]), "=&v"(r[0][2]), "=&v"(r[0][3]), "=&v"(r[1][0]), "=&v"(r[1][1]), "=&v"(r[1][2]), "=&v"(r[1][3]) : "v"(lds_u32(q)) : "memory");
}
__device__ __forceinline__ void ob_flush(LAS unsigned char* ob, unsigned char* dst, int rbase, int segb, int colbyte, int tid) {
    v4u xv[2];
    asm volatile("ds_read_b128 %0, %2\n\tds_read_b128 %1, %2 offset:%3\n\ts_waitcnt lgkmcnt(0)" : "=&v"(xv[0]), "=&v"(xv[1]) : "v"(lds_u32(ob + (tid >> 3) * OB_PITCH + (tid & 7) * 16)), "n"(64 * OB_PITCH) : "memory");
#pragma unroll
    for (int hh = 0; hh < 2; ++hh) { const int row = hh * 64 + (tid >> 3), c16 = tid & 7;
        *(v4u*)(dst + (unsigned)((rbase + row) * segb + colbyte + c16 * 16)) = xv[hh]; }
}
struct EpiAct {
    static constexpr bool PERM = true, BIAS_LDS = true, RS_LDS = true; static constexpr int NVM = 4;
    const float* bg; const float* bu; const float* rs; LAS unsigned char* ob; LAS unsigned char* bl; LAS unsigned char* rl; unsigned char* dump;
    __device__ __forceinline__ const float* bias_src(const gg::Unit& u, int lane) const { return (lane < 32 ? bg : bu) + u.e * FF + u.pn * 128 + 4 * (lane & 31); }
    __device__ __forceinline__ const float* rs_src(const gg::Unit& u, int lane) const { return rs + (size_t)u.e * NTOK + u.r0 + 4 * lane; }
    __device__ __forceinline__ void operator()(const f32x4 (&acc)[2][2][4][2], const gg::Unit& u, int wr, int wc, int fr, int fq) const {
        const int tid = (wr * 4 + wc) * 64 + fq * 16 + fr;
        const LAS float* bs = (const LAS float*)(bl + (wr * 4 + wc) * 1024) + wc * 32 + 8 * fq;
        f32x4 g0, g1, u0p, u1p; lds_read_bias4(bs, g0, g1, u0p, u1p); u0p = u0p + 1.0f; u1p = u1p + 1.0f;
        float rsv[2][4];
#pragma unroll
        for (int ai = 0; ai < 2; ++ai)
#pragma unroll
            for (int m = 0; m < 4; ++m) rsv[ai][m] = 0.f;
        lds_read_rs8((const LAS float*)rl + wr * 64 + fr, rsv);
#pragma unroll
        for (int ai = 0; ai < 2; ++ai)
#pragma unroll
            for (int m = 0; m < 4; ++m) rsv[ai][m] *= WINV;
#pragma unroll
        for (int ai = 0; ai < 2; ++ai) {
#pragma unroll
            for (int m = 0; m < 4; ++m) {
                const float sc = rsv[ai][m];
                float r[8];
#pragma unroll
                for (int n = 0; n < 2; ++n) { const f32x4 av = acc[ai][0][m][n], uv = acc[ai][1][m][n], gb4 = n ? g1 : g0, ub4 = n ? u1p : u0p;
#pragma unroll
                    for (int h = 0; h < 2; ++h) {
                        const hg2 a2 = {av[2 * h], av[2 * h + 1]}, u2 = {uv[2 * h], uv[2 * h + 1]}, gb = {gb4[2 * h], gb4[2 * h + 1]}, ub = {ub4[2 * h], ub4[2 * h + 1]};
                        hg2 gt = a2 * sc + gb; gt.x = fminf(gt.x, 7.0f); gt.y = fminf(gt.y, 7.0f);
                        const hg2 ea = gt * (-2.4554669595930157f);
                        hg2 den; den.x = ex2f_(ea.x); den.y = ex2f_(ea.y); den = den + 1.0f;
                        hg2 rc; rc.x = rcpf_(den.x); rc.y = rcpf_(den.y);
                        hg2 up1 = u2 * sc + ub;
                        up1.x = __builtin_amdgcn_fmed3f(up1.x, -6.0f, 8.0f); up1.y = __builtin_amdgcn_fmed3f(up1.y, -6.0f, 8.0f);
                        const hg2 rr = up1 * (gt * rc);
                        r[4 * n + 2 * h] = rr.x; r[4 * n + 2 * h + 1] = rr.y; } }
                v2u w; w.x = pk4_fp8(r[0], r[1], r[2], r[3]); w.y = pk4_fp8(r[4], r[5], r[6], r[7]);
                *(LAS v2u*)(ob + (wr * 64 + m * 16 + fr) * OB_PITCH + wc * 32 + 8 * fq) = w; }
            EPI_LDS_SYNC();
            ob_flush(ob, u.dst, ai * 128, 128, 0, tid);
            if (ai == 0) EPI_LDS_SYNC();
        }
    }
};
struct EpiDown {
    static constexpr bool PERM = true, BIAS_LDS = true, RS_LDS = false; static constexpr int NVM = 8;
    const float* bd; LAS unsigned char* ob; LAS unsigned char* bl; unsigned char* dump;
    __device__ __forceinline__ const float* bias_src(const gg::Unit& u, int lane) const { return bd + u.e * D + u.pn * 256 + 4 * lane; }
    __device__ __forceinline__ void operator()(const f32x4 (&acc)[2][2][4][2], const gg::Unit& u, int wr, int wc, int fr, int fq) const {
        const int tid = (wr * 4 + wc) * 64 + fq * 16 + fr;
        const LAS float* bs = (const LAS float*)(bl + (wr * 4 + wc) * 1024) + wc * 32 + 8 * fq;
        f32x4 bv[2][2]; lds_read_bias4(bs, bv[0][0], bv[0][1], bv[1][0], bv[1][1]);
        constexpr int SP = 272;
#pragma unroll
        for (int ai = 0; ai < 2; ++ai)
#pragma unroll
            for (int mh = 0; mh < 2; ++mh) {
#pragma unroll
                for (int mm = 0; mm < 2; ++mm)
#pragma unroll
                    for (int bj = 0; bj < 2; ++bj) { const int m = 2 * mh + mm; const f32x4 v0 = acc[ai][bj][m][0] * WINV + bv[bj][0], v1 = acc[ai][bj][m][1] * WINV + bv[bj][1];
                        v2u w; w.x = pk4_fp8(v0[0], v0[1], v0[2], v0[3]); w.y = pk4_fp8(v1[0], v1[1], v1[2], v1[3]);
                        *(LAS v2u*)(ob + (wr * 32 + mm * 16 + fr) * SP + bj * 128 + wc * 32 + 8 * fq) = w; }
                EPI_LDS_SYNC();
                { const int lr = tid >> 4, c16 = tid & 15; v4u xv[2];
                  asm volatile("ds_read_b128 %0, %2\n\tds_read_b128 %1, %2 offset:%3\n\ts_waitcnt lgkmcnt(0)" : "=&v"(xv[0]), "=&v"(xv[1]) : "v"(lds_u32(ob + lr * SP + c16 * 16)), "n"(32 * SP) : "memory");
                  const int tr = ai * 128 + (2 * mh + (lr >> 4)) * 16 + (lr & 15);
                  unsigned char* const yb = dump + (size_t)u.tile * 262144 + u.pn * 1024;
                  *(v4u*)(yb + (unsigned)((tr >> 2) * 4096 + (tr & 3) * 256 + c16 * 16)) = xv[0];
                  *(v4u*)(yb + (unsigned)(((tr + 64) >> 2) * 4096 + (tr & 3) * 256 + c16 * 16)) = xv[1]; }
                if (!(ai == 1 && mh == 1)) EPI_LDS_SYNC();
            }
    }
};
__device__ __forceinline__ int vcu_of(const Frame& F) { return (F.G % 8 == 0) ? (F.bid % 8) * (F.G / 8) + F.bid / 8 : F.bid; }
__device__ __forceinline__ void phase_gateup(const Params& p, Frame& F) {
    LAS int* sb = (LAS int*)(F.lds + LDS_TAB); load_tables(p, F, sb);
    MoeSched<8, true> S; S.A = (const char*)(p.ws + WS_H8); S.W = (const char*)(p.ws + WS_WGU8); S.list = (const int*)(p.ws + WS_LIST); S.init(sb, F);
    S.dstbase = p.ws + WS_ACT8; S.dpitch = FF;
    EpiAct E{p.b_gate, p.b_up, (const float*)(p.ws + WS_RS), F.lds + LDS_OB, F.lds + LDS_BIAS, F.lds + LDS_RS, p.ws + WS_ACT8 + (size_t)4 * NTOK * FF};
    gg::gemm_phase<MoeSched<8, true>, EpiAct>(F.lds, S, E);
    {
        const int rem = S.rem(), per = rem ? S.PX - rem : 0, nidle = per * (F.G / S.PX);
        __syncthreads();
        CvJob cv;
        if (nidle >= 64) { if (S.j >= rem) { cv.init(2, CV_WD_A + (S.x * per + S.j - rem) * NWAVES + F.wave, nidle * NWAVES, CV_WD); cv.rest(p, F.lds + F.wave * CV_LDS, F.lane); } }
        else { cv.init(2, CV_WD_A + F.gw, F.NGW, CV_WD); cv.rest(p, F.lds + F.wave * CV_LDS, F.lane); }
    }
}
__device__ __forceinline__ void phase_down(const Params& p, Frame& F) {
    LAS int* sb = (LAS int*)(F.lds + LDS_TAB); if (p.ph_lo > 6) load_tables(p, F, sb);
    MoeSched<4, false> S; S.A = (const char*)(p.ws + WS_ACT8); S.W = (const char*)(p.ws + WS_WD8); S.list = nullptr; S.init(sb, F);
    S.dstbase = p.ws + WS_YSD; S.dpitch = D;
    EpiDown E{p.b_down, F.lds + LDS_OB, F.lds + LDS_BIAS, p.ws + WS_YSD};
    gg::gemm_phase<MoeSched<4, false>, EpiDown>(F.lds, S, E);
}

namespace hg {
constexpr int LDK = 136, LDS_ = 72, LDO = 132;
constexpr int OFF_ST = 0, OFF_QD = OFF_ST + 128 * LDK * 2, OFF_QP = OFF_QD + 64 * LDK * 2, OFF_KP = OFF_QP + 64 * LDK * 2, OFF_KDT = OFF_KP + 64 * LDK * 2,
              OFF_VT = OFF_KDT + 128 * LDS_ * 2, OFF_P = OFF_VT + 128 * LDS_ * 2, OFF_TOT = OFF_P + 64 * LDS_ * 2, OFF_DV = OFF_TOT + 4096, OFF_SQW = OFF_DV + 512, OFF_END = OFF_SQW + 2048, OFF_O = OFF_QD;
static_assert(64 * LDO * 4 <= 2 * 64 * LDK * 2 && OFF_END <= 140000, "hgrn LDS map");
typedef float f32x2 __attribute__((ext_vector_type(2)));
#define HG_LDF(off) (*(const LAS bf16x8*)(lds + (off)))
__device__ __forceinline__ f32x2 unpk2(unsigned raw) { return (f32x2){__uint_as_float(raw << 16), __uint_as_float(raw & 0xffff0000u)}; }
__device__ __forceinline__ f32x2 ex2v(f32x2 v) { return (f32x2){ex2f_(v.x), ex2f_(v.y)}; }
__device__ __forceinline__ f32x2 lg2v(f32x2 v) { return (f32x2){lg2f_(v.x), lg2f_(v.y)}; }
__device__ __forceinline__ f32x2 rcpv(f32x2 v) { return (f32x2){rcpf_(v.x), rcpf_(v.y)}; }
__device__ __forceinline__ f32x2 min2(f32x2 v, float c) { return (f32x2){fminf(v.x, c), fminf(v.y, c)}; }
__device__ __forceinline__ f32x2 sig2(f32x2 z) { return rcpv(ex2v(z * (-1.4426950408889634f)) + 1.0f); }
__device__ __forceinline__ unsigned pk2v(f32x2 v) { return pk2(v.x, v.y); }

template <bool PASS_B>
__device__ __forceinline__ void hgrn_unit(const Params& p, Frame& F, int unit, CvJob* cv) {
    LAS unsigned char* lds = F.lds;
    const bf16* PROJ = (const bf16*)(p.ws + WS_PROJ); bf16* MIX = (bf16*)(p.ws + WS_MIX);
    float* HST = (float*)(p.ws + WS_HST); float* HDEC = (float*)(p.ws + WS_HDEC);
    const int b = unit >> 6, h = (unit >> 4) & 3, seg = unit & 15;
    const int lane = F.lane, w = F.wave, fr = lane & 15, q = lane >> 4, cp = lane, tg = w;
    const int ch = h * HD + 2 * cp;
    f32x2 lb2; { const float a0 = p.hgrn_lb[ch], a1 = p.hgrn_lb[HW + ch], c0 = p.hgrn_lb[ch + 1], c1 = p.hgrn_lb[HW + ch + 1]; lb2.x = rcpf_(1.0f + __expf(a1 - a0)); lb2.y = rcpf_(1.0f + __expf(c1 - c0)); }
    const f32x2 oml2 = 1.0f - lb2;
    const f32x2 ng2 = {p.hgrn_norm_g[2 * cp], p.hgrn_norm_g[2 * cp + 1]};
    f32x4 acc_s[8];
#pragma unroll
    for (int kt = 0; kt < 8; ++kt) acc_s[kt] = (f32x4){0.f, 0.f, 0.f, 0.f};
    f32x2 segsum2 = {0.f, 0.f};
    if (PASS_B) {
        LAS float* Wt = (LAS float*)(lds + OFF_QD);
        if (F.tid < 128) { float dv[15];
#pragma unroll
            for (int j = 0; j < 15; ++j) { const int jc = (j < seg) ? j : (seg > 0 ? seg - 1 : 0); dv[j] = HDEC[(unit - seg + jc) * 128 + F.tid]; }
#pragma unroll
            for (int j = 0; j < 15; ++j) asm volatile("" : "+v"(dv[j]));
            float run = 1.0f;
#pragma unroll
            for (int j = 14; j >= 0; --j) { Wt[j * 128 + F.tid] = run; run *= (j < seg) ? dv[j] : 1.0f; } }
        LDS_SYNC();
        for (int j0 = 0; j0 < seg; j0 += 5) {
            v4u e4[5][4];
#pragma unroll
            for (int u = 0; u < 5; ++u) { const int j = (j0 + u < seg) ? j0 + u : seg - 1; const unsigned char* hs = (const unsigned char*)HST + (size_t)(unit - seg + j) * 32768 + (size_t)w * 4096 + lane * 16;
#pragma unroll
                for (int kp = 0; kp < 4; ++kp) e4[u][kp] = *(const v4u*)(hs + kp * 1024); }
#pragma unroll
            for (int u = 0; u < 5; ++u) { const bool ok = j0 + u < seg; const int j = ok ? j0 + u : seg - 1;
#pragma unroll
                for (int kt = 0; kt < 8; ++kt) { f32x4 w4 = *(const LAS f32x4*)(Wt + j * 128 + 16 * kt + 4 * q); if (!ok) w4 = (f32x4){0.f, 0.f, 0.f, 0.f};
                    const unsigned r0 = (kt & 1) ? e4[u][kt >> 1].z : e4[u][kt >> 1].x, r1 = (kt & 1) ? e4[u][kt >> 1].w : e4[u][kt >> 1].y;
                    const f32x4 ev = {__uint_as_float(r0 << 16), __uint_as_float(r0 & 0xffff0000u), __uint_as_float(r1 << 16), __uint_as_float(r1 & 0xffff0000u)};
                    acc_s[kt] = acc_s[kt] + w4 * ev; } } }
        LDS_SYNC();
#pragma unroll
        for (int kt = 0; kt < 8; ++kt) { v2u wv; wv.x = pk2(acc_s[kt][0], acc_s[kt][1]); wv.y = pk2(acc_s[kt][2], acc_s[kt][3]); *(LAS v2u*)(lds + OFF_ST + ((16 * w + fr) * LDK + 16 * kt + 4 * q) * 2) = wv; }
    }
    unsigned nq[8], nf[8], nv[8], ngr[8];
    if (PASS_B) { const bf16* base = PROJ + (size_t)(b * SEQ + seg * 512 + 8 * tg) * INC + ch;
#pragma unroll
      for (int i = 0; i < 8; ++i) { const bf16* r = base + (size_t)i * INC; nf[i] = *(const unsigned*)(r + HW); nv[i] = *(const unsigned*)(r + 2 * HW); nq[i] = *(const unsigned*)r; ngr[i] = *(const unsigned*)(r + 3 * HW); } }
    for (int c = 0; c < 8; ++c) {
        const int row0 = b * SEQ + seg * 512 + c * 64 + 8 * tg;
        unsigned qraw[8], fraw[8], vraw[8], graw[8];
        if (PASS_B) {
#pragma unroll
            for (int i = 0; i < 8; ++i) { qraw[i] = nq[i]; fraw[i] = nf[i]; vraw[i] = nv[i]; graw[i] = ngr[i]; }
            if (c < 7) { const bf16* base = PROJ + (size_t)(row0 + 64) * INC + ch;
#pragma unroll
                for (int i = 0; i < 8; ++i) { const bf16* r = base + (size_t)i * INC; nf[i] = *(const unsigned*)(r + HW); nv[i] = *(const unsigned*)(r + 2 * HW); nq[i] = *(const unsigned*)r; ngr[i] = *(const unsigned*)(r + 3 * HW); } }
        } else {
            const bf16* base = PROJ + (size_t)row0 * INC + ch;
#pragma unroll
            for (int i = 0; i < 8; ++i) { const bf16* r = base + (size_t)i * INC; fraw[i] = *(const unsigned*)(r + HW); vraw[i] = *(const unsigned*)(r + 2 * HW); qraw[i] = 0u; graw[i] = 0u; }
#pragma unroll
            for (int i = 0; i < 8; ++i) asm volatile("" : "+v"(fraw[i]), "+v"(vraw[i]));
            if (cv) cv->top(p, lane);
        }
        f32x2 k2[8], b2[8];
        { f32x2 s2 = {0.f, 0.f};
#pragma unroll
          for (int i = 0; i < 8; ++i) { const f32x2 f2 = lb2 + oml2 * sig2(unpk2(fraw[i])); k2[i] = 1.0f - f2; s2 += lg2v(f2); b2[i] = s2; }
          *(LAS f32x2*)(lds + OFF_TOT + (tg * 128 + 2 * cp) * 4) = s2; }
        LDS_SYNC();
        f32x2 off2 = {0.f, 0.f}, bl2 = {0.f, 0.f}, bm2 = {0.f, 0.f};
#pragma unroll
        for (int g = 0; g < 8; ++g) { const f32x2 t2 = *(const LAS f32x2*)(lds + OFF_TOT + (g * 128 + 2 * cp) * 4); if (g < tg) off2 += t2; if (g < 4) bm2 += t2; bl2 += t2; }
        segsum2 += bl2;
        if (tg == 0) *(LAS f32x2*)(lds + OFF_DV + 2 * cp * 4) = ex2v(bl2);
        const f32x2 cq2 = ex2v(bm2), ck2 = ex2v(bl2 - bm2);
        { unsigned kkv[8];
#pragma unroll
          for (int i = 0; i < 8; ++i) { const f32x2 bb2 = off2 + b2[i];
              unsigned kk;
              if (PASS_B) { const f32x2 qp = unpk2(qraw[i]); const f32x2 q2 = qp * sig2(qp);
                  const int t = 8 * tg + i;
                  const f32x2 qe = q2 * ex2v(min2(bb2 - bm2, 115.f)), ke = k2[i] * ex2v(min2(bm2 - bb2, 115.f));
                  *(LAS unsigned*)(lds + OFF_QD + (t * LDK + 2 * cp) * 2) = pk2v(qe * cq2);
                  *(LAS unsigned*)(lds + OFF_QP + (t * LDK + 2 * cp) * 2) = pk2v(qe);
                  *(LAS unsigned*)(lds + OFF_KP + (t * LDK + 2 * cp) * 2) = pk2v(ke);
                  kk = pk2v(ke * ck2); }
              else kk = pk2v(k2[i] * ex2v(bl2 - bb2));
              kkv[i] = kk; }
          constexpr unsigned SEL_LO = 0x05040100u, SEL_HI = 0x07060302u;
          v4u x; x.x = perm_b32(kkv[1], kkv[0], SEL_LO); x.y = perm_b32(kkv[3], kkv[2], SEL_LO); x.z = perm_b32(kkv[5], kkv[4], SEL_LO); x.w = perm_b32(kkv[7], kkv[6], SEL_LO); *(LAS v4u*)(lds + OFF_KDT + ((2 * cp) * LDS_ + 8 * tg) * 2) = x;
          x.x = perm_b32(kkv[1], kkv[0], SEL_HI); x.y = perm_b32(kkv[3], kkv[2], SEL_HI); x.z = perm_b32(kkv[5], kkv[4], SEL_HI); x.w = perm_b32(kkv[7], kkv[6], SEL_HI); *(LAS v4u*)(lds + OFF_KDT + ((2 * cp + 1) * LDS_ + 8 * tg) * 2) = x;
          x.x = perm_b32(vraw[1], vraw[0], SEL_LO); x.y = perm_b32(vraw[3], vraw[2], SEL_LO); x.z = perm_b32(vraw[5], vraw[4], SEL_LO); x.w = perm_b32(vraw[7], vraw[6], SEL_LO); *(LAS v4u*)(lds + OFF_VT + ((2 * cp) * LDS_ + 8 * tg) * 2) = x;
          x.x = perm_b32(vraw[1], vraw[0], SEL_HI); x.y = perm_b32(vraw[3], vraw[2], SEL_HI); x.z = perm_b32(vraw[5], vraw[4], SEL_HI); x.w = perm_b32(vraw[7], vraw[6], SEL_HI); *(LAS v4u*)(lds + OFF_VT + ((2 * cp + 1) * LDS_ + 8 * tg) * 2) = x; }
        LDS_SYNC();
        f32x4 acc_o[4];
        if (PASS_B) {
#pragma unroll
            for (int ti = 0; ti < 4; ++ti) acc_o[ti] = (f32x4){0.f, 0.f, 0.f, 0.f};
#pragma unroll
            for (int ks = 0; ks < 4; ++ks) { const bf16x8 a = HG_LDF(OFF_ST + ((16 * w + fr) * LDK + 32 * ks + 8 * q) * 2);
#pragma unroll
                for (int ti = 0; ti < 4; ++ti) { const bf16x8 bq = HG_LDF(OFF_QD + ((16 * ti + fr) * LDK + 32 * ks + 8 * q) * 2); acc_o[ti] = __builtin_amdgcn_mfma_f32_16x16x32_bf16(a, bq, acc_o[ti], 0, 0, 0); } }
            { const int ti = w >> 1;
#pragma unroll
              for (int sj = 0; sj < 2; ++sj) { const int si = 2 * (w & 1) + sj; f32x4 ap = (f32x4){0.f, 0.f, 0.f, 0.f};
                  if (si <= ti) {
#pragma unroll
                      for (int ks = 0; ks < 4; ++ks) { const bf16x8 a = HG_LDF(OFF_KP + ((16 * si + fr) * LDK + 32 * ks + 8 * q) * 2), bq = HG_LDF(OFF_QP + ((16 * ti + fr) * LDK + 32 * ks + 8 * q) * 2);
                          ap = __builtin_amdgcn_mfma_f32_16x16x32_bf16(a, bq, ap, 0, 0, 0); } }
                  const int t = 16 * ti + fr, s0 = 16 * si + 4 * q;
                  const float p0 = (si <= ti && s0 + 0 <= t) ? ap[0] : 0.f, p1 = (si <= ti && s0 + 1 <= t) ? ap[1] : 0.f, p2 = (si <= ti && s0 + 2 <= t) ? ap[2] : 0.f, p3 = (si <= ti && s0 + 3 <= t) ? ap[3] : 0.f;
                  v2u wv; wv.x = pk2(p0, p1); wv.y = pk2(p2, p3); *(LAS v2u*)(lds + OFF_P + (t * LDS_ + s0) * 2) = wv; } }
            LDS_SYNC();
        }
        { bf16x8 vt[2];
#pragma unroll
          for (int ss = 0; ss < 2; ++ss) vt[ss] = HG_LDF(OFF_VT + ((16 * w + fr) * LDS_ + 32 * ss + 8 * q) * 2);
          if (PASS_B) {
#pragma unroll
              for (int ss = 0; ss < 2; ++ss)
#pragma unroll
                  for (int ti = 0; ti < 4; ++ti) { if (ss == 1 && ti < 2) continue; const bf16x8 bp = HG_LDF(OFF_P + ((16 * ti + fr) * LDS_ + 32 * ss + 8 * q) * 2); acc_o[ti] = __builtin_amdgcn_mfma_f32_16x16x32_bf16(vt[ss], bp, acc_o[ti], 0, 0, 0); }
          }
#pragma unroll
          for (int kt = 0; kt < 8; ++kt) { const f32x4 d4 = *(const LAS f32x4*)(lds + OFF_DV + (16 * kt + 4 * q) * 4); acc_s[kt] = acc_s[kt] * d4;
#pragma unroll
              for (int ss = 0; ss < 2; ++ss) { const bf16x8 a = HG_LDF(OFF_KDT + ((16 * kt + fr) * LDS_ + 32 * ss + 8 * q) * 2); acc_s[kt] = __builtin_amdgcn_mfma_f32_16x16x32_bf16(a, vt[ss], acc_s[kt], 0, 0, 0); } }
        }
        if (PASS_B) {
#pragma unroll
            for (int ti = 0; ti < 4; ++ti) { *(LAS f32x4*)(lds + OFF_O + ((16 * ti + fr) * LDO + 16 * w + 4 * q) * 4) = acc_o[ti];
                float sq = (acc_o[ti][0] * acc_o[ti][0] + acc_o[ti][1] * acc_o[ti][1]) + (acc_o[ti][2] * acc_o[ti][2] + acc_o[ti][3] * acc_o[ti][3]);
                sq += __shfl_xor(sq, 16); sq += __shfl_xor(sq, 32);
                if (q == 0) *(LAS float*)(lds + OFF_SQW + ((16 * ti + fr) * 8 + w) * 4) = sq; }
#pragma unroll
            for (int kt = 0; kt < 8; ++kt) { v2u wv; wv.x = pk2(acc_s[kt][0], acc_s[kt][1]); wv.y = pk2(acc_s[kt][2], acc_s[kt][3]); *(LAS v2u*)(lds + OFF_ST + ((16 * w + fr) * LDK + 16 * kt + 4 * q) * 2) = wv; }
            LDS_SYNC();
#pragma unroll
            for (int i = 0; i < 8; ++i) { const int t = 8 * tg + i; const f32x2 o2 = *(const LAS f32x2*)(lds + OFF_O + (t * LDO + 2 * cp) * 4);
                const f32x4 sa = *(const LAS f32x4*)(lds + OFF_SQW + t * 32), sb4 = *(const LAS f32x4*)(lds + OFF_SQW + t * 32 + 16);
                const float ss = ((sa[0] + sa[1]) + (sa[2] + sa[3])) + ((sb4[0] + sb4[1]) + (sb4[2] + sb4[3])); const float rstd = rsqf_(ss * (1.0f / HD) + EPS);
                const f32x2 gv = unpk2(graw[i]);
                *(unsigned*)(MIX + (size_t)(row0 + i) * D + ch) = pk2v(o2 * rstd * ng2 * (gv * sig2(gv))); }
        }
        if (!PASS_B && cv) cv->bottom(lds + OFF_ST + w * CV_LDS, lane);
    }
    if (!PASS_B) {
        unsigned char* hs = (unsigned char*)HST + (size_t)unit * 32768 + (size_t)w * 4096 + lane * 16;
#pragma unroll
        for (int kp = 0; kp < 4; ++kp) { v4u wv; wv.x = pk2(acc_s[2 * kp][0], acc_s[2 * kp][1]); wv.y = pk2(acc_s[2 * kp][2], acc_s[2 * kp][3]); wv.z = pk2(acc_s[2 * kp + 1][0], acc_s[2 * kp + 1][1]); wv.w = pk2(acc_s[2 * kp + 1][2], acc_s[2 * kp + 1][3]);
            *(v4u*)(hs + kp * 1024) = wv; }
        if (tg == 0) *(f32x2*)(HDEC + unit * 128 + 2 * cp) = ex2v(segsum2);
    }
    LDS_SYNC();
}

__device__ __forceinline__ void pool_unit(const Params& p, Frame& F, int unit) {
    LAS unsigned char* lds = F.lds;
    const bf16* PROJ = (const bf16*)(p.ws + WS_PROJ); bf16* MIX = (bf16*)(p.ws + WS_MIX); const bf16* POOLT = (const bf16*)(p.ws + WS_POOLT);
    const int lane = F.lane, w = F.wave, fr = lane & 15, q = lane >> 4, cp = lane, tg = w;
    const int tok0 = unit * 64, t0 = tok0 + 8 * tg, s0 = t0 % SEQ;
    constexpr int OUTP = 1040;
    LAS unsigned char* const outb = lds + 64 * hg::LDK * 2;
    unsigned rawv[4][23]; bf16x8 wa[4][4]; f32x4 scv[4];
    auto gload = [&](int g) { const int win = 2 << g, nrow = 8 + win - 1; const bf16* col = PROJ + (size_t)t0 * INC + 4 * HW + g * 128 + 2 * cp;
#pragma unroll
        for (int j = 0; j < 23; ++j) { rawv[g][j] = 0u; if (j < nrow) { const int rel = j - (win - 1); const bool ok = s0 + rel >= 0; const int relc = ok ? rel : -s0;
                const unsigned raw = *(const unsigned*)(col + (ptrdiff_t)relc * INC); rawv[g][j] = ok ? raw : 0u; } }
#pragma unroll
        for (int ks = 0; ks < 4; ++ks) wa[g][ks] = *(const bf16x8*)(POOLT + (size_t)g * 16384 + (16 * w + fr) * 128 + 32 * ks + 8 * q);
        scv[g] = *(const f32x4*)(p.pool_scale + g * 128 + 16 * w + 4 * q); };
    gload(0);
#pragma unroll
    for (int g = 0; g < 4; ++g) {
        constexpr int dummy = 0; (void)dummy;
        const int win = 2 << g, nrow = 8 + win - 1;
        if (g < 3) gload(g + 1);
        f32x2 u[23];
#pragma unroll
        for (int j = 0; j < 23; ++j) u[j] = unpk2(rawv[g][j]);
        f32x2 a[23];
#pragma unroll
        for (int j = 0; j < 23; ++j) a[j] = u[j];
#pragma unroll
        for (int st = 1; st < 16; st <<= 1) if (st < win) {
#pragma unroll
            for (int j = 0; j < 23; ++j) if (j + st < 23 && j + 2 * st <= nrow) a[j] = a[j] + a[j + st]; }
#pragma unroll
        for (int i = 0; i < 8; ++i) { const int n = (s0 + i + 1 < win) ? (s0 + i + 1) : win; const float inv = rcpf_((float)n);
            *(LAS unsigned*)(lds + ((8 * tg + i) * hg::LDK + 2 * cp) * 2) = pk2v(a[i] * inv - u[i + win - 1]); }
        LDS_SYNC();
        f32x4 acc[4];
#pragma unroll
        for (int ti = 0; ti < 4; ++ti) acc[ti] = (f32x4){0.f, 0.f, 0.f, 0.f};
#pragma unroll
        for (int ks = 0; ks < 4; ++ks) { const bf16x8 av = wa[g][ks];
#pragma unroll
            for (int ti = 0; ti < 4; ++ti) { const bf16x8 bq = *(const LAS bf16x8*)(lds + ((16 * ti + fr) * hg::LDK + 32 * ks + 8 * q) * 2); acc[ti] = __builtin_amdgcn_mfma_f32_16x16x32_bf16(av, bq, acc[ti], 0, 0, 0); } }
        const f32x4 sc = scv[g];
#pragma unroll
        for (int ti = 0; ti < 4; ++ti) { v2u wv; wv.x = pk2(acc[ti][0] * sc[0], acc[ti][1] * sc[1]); wv.y = pk2(acc[ti][2] * sc[2], acc[ti][3] * sc[3]);
            *(LAS v2u*)(outb + (16 * ti + fr) * OUTP + (g * 128 + 16 * w + 4 * q) * 2) = wv; }
        LDS_SYNC();
    }
#pragma unroll
    for (int ps = 0; ps < 8; ++ps) { const int row = ps * 8 + (F.tid >> 6), c16 = F.tid & 63;
        *(v4u*)(MIX + (size_t)(tok0 + row) * D + HW + c16 * 8) = *(const LAS v4u*)(outb + row * OUTP + c16 * 16); }
    LDS_SYNC();
}
}
__device__ __forceinline__ int hgrn_unit_of(int u, int G) { if (G != 256) return u; const int x = u & 7, jj = u >> 3; return ((2 * x + (jj >> 4)) << 4) | (jj & 15); }
__device__ __forceinline__ void phase_mixA(const Params& p, Frame& F) {
    for (int u = F.bid; u < 256; u += F.G) hg::hgrn_unit<false>(p, F, hgrn_unit_of(u, F.G), nullptr);
    for (int u = F.bid; u < NTOK / 64; u += F.G) hg::pool_unit(p, F, u);
}
__device__ __forceinline__ void phase_mixB(const Params& p, Frame& F) {
    for (int u = F.bid; u < 256; u += F.G) hg::hgrn_unit<true>(p, F, hgrn_unit_of(u, F.G), nullptr);
}

namespace rt {
constexpr int LG_STRIDE = 33;
constexpr int SLAB = 128 * LG_STRIDE * 4, OFF_LGW = 0, OFF_SQW = OFF_LGW + 8 * SLAB, OFF_SQ = OFF_SQW + 8 * 128 * 4, OFF_TE = OFF_SQ + 512, OFF_TG = OFF_TE + 2048, OFF_CNT = OFF_TG + 2048, OFF_BASE = OFF_CNT + 128,
              OFF_HS = OFF_BASE + 128, OFF_END = OFF_HS + 8 * 2304;
static_assert(OFF_END <= LDS_BYTES - 64, "route LDS map");
__device__ __forceinline__ void split8(const f32x4 a, const f32x4 b, bf16x8& hi, bf16x8& lo) {
    const float v[8] = {a[0], a[1], a[2], a[3], b[0], b[1], b[2], b[3]};
    unsigned h[4], l[4];
#pragma unroll
    for (int j = 0; j < 4; ++j) { h[j] = pk2(v[2 * j], v[2 * j + 1]); l[j] = pk2(v[2 * j] - __uint_as_float(h[j] << 16), v[2 * j + 1] - __uint_as_float(h[j] & 0xffff0000u)); }
    hi = __builtin_bit_cast(bf16x8, (v4u){h[0], h[1], h[2], h[3]}); lo = __builtin_bit_cast(bf16x8, (v4u){l[0], l[1], l[2], l[3]});
}
}
__device__ __forceinline__ void phase_route(const Params& p, Frame& F) {
    LAS unsigned char* lds = F.lds;
    unsigned char* H8 = p.ws + WS_H8; unsigned* ctl = (unsigned*)(p.ws + WS_CTL); const bf16* X1B = (const bf16*)(p.ws + WS_X1B);
    int* LIST = (int*)(p.ws + WS_LIST); int* TOKES = (int*)(p.ws + WS_TOKES); float* TOKG = (float*)(p.ws + WS_TOKGATE);
    const bf16* WRH = (const bf16*)(p.ws + WS_WRH); const bf16* WRL = (const bf16*)(p.ws + WS_WRL); float* RS = (float*)(p.ws + WS_RS);
    const int lane = F.lane, w = F.wave, fr = lane & 15, q = lane >> 4, tid = F.tid;
    f32x4 g2a[4], g2b[4];
#pragma unroll
    for (int ks = 0; ks < 4; ++ks) { g2a[ks] = *(const f32x4*)(p.norm2_g + 128 * w + 32 * ks + 8 * q); g2b[ks] = *(const f32x4*)(p.norm2_g + 128 * w + 32 * ks + 8 * q + 4); }
    LAS unsigned char* hs = lds + rt::OFF_HS + w * 2304;
    bf16x8 wh[2][4], wl[2][4];
#pragma unroll
    for (int nt = 0; nt < 2; ++nt)
#pragma unroll
        for (int ks = 0; ks < 4; ++ks) { const size_t o = (size_t)(16 * nt + fr) * D + 128 * w + 32 * ks + 8 * q; wh[nt][ks] = *(const bf16x8*)(WRH + o); wl[nt][ks] = *(const bf16x8*)(WRL + o); }
    LAS float* LGW = (LAS float*)(lds + rt::OFF_LGW); LAS float* SQW = (LAS float*)(lds + rt::OFF_SQW); LAS float* SQ = (LAS float*)(lds + rt::OFF_SQ);
    LAS float* const lgw = LGW + w * (rt::SLAB / 4); LAS int* TE = (LAS int*)(lds + rt::OFF_TE); LAS float* TG = (LAS float*)(lds + rt::OFF_TG);
    LAS int* CNT = (LAS int*)(lds + rt::OFF_CNT); LAS int* BASE = (LAS int*)(lds + rt::OFF_BASE);
    const int nround = (NTOK / 128 + F.G - 1) / F.G;
    for (int it = 0; it < nround; ++it) {
        const int blk = it * F.G + F.bid; const bool active = blk < NTOK / 128; const int tok0 = blk * 128;
        __syncthreads();
        if (tid < 32) CNT[tid] = 0;
        __syncthreads();
        if (active) {
            v4u xa[4];
            { const bf16* xr = X1B + (size_t)(tok0 + 16 * w + fr) * D + 128 * w + 8 * q;
#pragma unroll
              for (int ks = 0; ks < 4; ++ks) xa[ks] = *(const v4u*)(xr + 32 * ks); }
#pragma unroll 1
            for (int ii = 0; ii < 8; ++ii) {
                const int i = (ii + w) & 7;
                v4u ca[4];
#pragma unroll
                for (int ks = 0; ks < 4; ++ks) ca[ks] = xa[ks];
                if (ii < 7) { const bf16* xr = X1B + (size_t)(tok0 + 16 * ((i + 1) & 7) + fr) * D + 128 * w + 8 * q;
#pragma unroll
                    for (int ks = 0; ks < 4; ++ks) xa[ks] = *(const v4u*)(xr + 32 * ks); }
                f32x4 acc0 = {0.f, 0.f, 0.f, 0.f}, acc1 = {0.f, 0.f, 0.f, 0.f}; float sq = 0.f;
#pragma unroll
                for (int ks = 0; ks < 4; ++ks) { const v4u xw = ca[ks];
                    const f32x4 a = {__uint_as_float(xw.x << 16), __uint_as_float(xw.x & 0xffff0000u), __uint_as_float(xw.y << 16), __uint_as_float(xw.y & 0xffff0000u)};
                    const f32x4 b = {__uint_as_float(xw.z << 16), __uint_as_float(xw.z & 0xffff0000u), __uint_as_float(xw.w << 16), __uint_as_float(xw.w & 0xffff0000u)};
                    sq += (a[0] * a[0] + a[1] * a[1]) + (a[2] * a[2] + a[3] * a[3]) + (b[0] * b[0] + b[1] * b[1]) + (b[2] * b[2] + b[3] * b[3]);
                    { const f32x4 ya = a * g2a[ks], yb = b * g2b[ks]; v2u hw; hw.x = pk4_fp8(ya[0], ya[1], ya[2], ya[3]); hw.y = pk4_fp8(yb[0], yb[1], yb[2], yb[3]);
                      *(LAS v2u*)(hs + fr * 144 + 32 * ks + 8 * q) = hw; }
                    const bf16x8 xh = __builtin_bit_cast(bf16x8, xw);
                    acc0 = __builtin_amdgcn_mfma_f32_16x16x32_bf16(xh, wh[0][ks], acc0, 0, 0, 0); acc0 = __builtin_amdgcn_mfma_f32_16x16x32_bf16(xh, wl[0][ks], acc0, 0, 0, 0);
                    acc1 = __builtin_amdgcn_mfma_f32_16x16x32_bf16(xh, wh[1][ks], acc1, 0, 0, 0); acc1 = __builtin_amdgcn_mfma_f32_16x16x32_bf16(xh, wl[1][ks], acc1, 0, 0, 0); }
                asm volatile("s_waitcnt lgkmcnt(0)" ::: "memory");
#pragma unroll
                for (int hh = 0; hh < 2; ++hh) { const int row = (lane >> 3) + 8 * hh, c16 = lane & 7; const v4u hv = *(const LAS v4u*)(hs + row * 144 + 16 * c16);
                    *(v4u*)(H8 + (size_t)(tok0 + 16 * i + row) * D + 128 * w + 16 * c16) = hv; }
                asm volatile("s_waitcnt lgkmcnt(0)" ::: "memory");
                sq += __shfl_xor(sq, 16); sq += __shfl_xor(sq, 32);
                if (q == 0) SQW[w * 128 + 16 * i + fr] = sq;
#pragma unroll
                for (int r = 0; r < 4; ++r) { lgw[(16 * i + 4 * q + r) * rt::LG_STRIDE + fr] = acc0[r]; lgw[(16 * i + 4 * q + r) * rt::LG_STRIDE + 16 + fr] = acc1[r]; }
            }
        }
        __syncthreads();
        if (active && tid < 128) {
            float ss = 0.f;
#pragma unroll
            for (int w8 = 0; w8 < 8; ++w8) ss += SQW[w8 * 128 + tid];
            const float rstd = rsqf_(ss * (1.0f / D) + EPS); SQ[tid] = rstd;
            float v[32];
#pragma unroll
            for (int e = 0; e < 32; ++e) { float a = 0.f;
#pragma unroll
                for (int w8 = 0; w8 < 8; ++w8) a += LGW[w8 * (rt::SLAB / 4) + tid * rt::LG_STRIDE + e];
                v[e] = a * rstd + p.router_b[e]; }
            float tv[4]; int te[4];
#pragma unroll
            for (int r = 0; r < 4; ++r) { float bv = -INFINITY; int bi = 0;
#pragma unroll
                for (int e = 0; e < 32; ++e) { if (v[e] > bv) { bv = v[e]; bi = e; } }
                tv[r] = bv; te[r] = bi;
#pragma unroll
                for (int e = 0; e < 32; ++e) if (e == bi) v[e] = -INFINITY; }
            const float e1 = __expf(tv[1] - tv[0]), e2 = __expf(tv[2] - tv[0]), e3 = __expf(tv[3] - tv[0]); const float inv = 1.0f / (1.0f + e1 + e2 + e3);
            TE[tid * 4 + 0] = te[0]; TE[tid * 4 + 1] = te[1]; TE[tid * 4 + 2] = te[2]; TE[tid * 4 + 3] = te[3];
            TG[tid * 4 + 0] = inv; TG[tid * 4 + 1] = e1 * inv; TG[tid * 4 + 2] = e2 * inv; TG[tid * 4 + 3] = e3 * inv;
        }
        __syncthreads();
        int ee = 0, lrank = 0;
        if (active) { ee = TE[tid]; lrank = __hip_atomic_fetch_add(CNT + ee, 1, __ATOMIC_RELAXED, __HIP_MEMORY_SCOPE_WORKGROUP); }
        __syncthreads();
        if (active && tid < 32) { const int c = CNT[tid]; BASE[tid] = c ? (int)atomicAdd(ctl + CW_CNT + 64 * tid, (unsigned)c) : 0; }
        __syncthreads();
        if (active) { const int tok = tok0 + (tid >> 2), slot = BASE[ee] + lrank;
            LIST[ee * NTOK + slot] = tok; TOKES[tok * 4 + (tid & 3)] = (ee << 16) | slot; TOKG[tok * 4 + (tid & 3)] = TG[tid]; RS[ee * NTOK + slot] = SQ[tid >> 2]; }
    }
}

constexpr int N_PHASES = 9;
constexpr unsigned DUP_MASK = 0x000u;
__global__ void __launch_bounds__(NTHREADS, 2) fwd(Params p) {
    extern __shared__ __attribute__((aligned(16))) unsigned char lds[];
    Frame F; F.lds = (LAS unsigned char*)lds; F.tid = threadIdx.x; F.lane = F.tid & 63; F.wave = __builtin_amdgcn_readfirstlane(F.tid >> 6);
    F.G = gridDim.x; F.bid = blockIdx.x; F.gw = F.bid * NWAVES + F.wave; F.NGW = F.G * NWAVES;
    volatile LAS unsigned* MISC = (volatile LAS unsigned*)(F.lds + LDS_BYTES - 64);
    if (F.tid < 16) MISC[F.tid] = 0u;
    __syncthreads();
    const int lo = p.ph_lo, hi = p.ph_hi;
    XcdBarrier bar; bar.bar = (unsigned*)(p.ws + WS_CTL) + CW_BAR; bar.x = 0; bar.st = nullptr;
    if (hi - lo > 1) bar = xcd_barrier_post((unsigned*)(p.ws + WS_CTL) + CW_BAR, MISC + 8);
#define IN(k) (lo <= (k) && (k) < hi)
#define SEAM(k) do { if (IN(k) && IN((k) + 1)) xcd_barrier(bar); } while (0)
#define RUN(k, call) do { if (IN(k)) { call; if ((DUP_MASK >> (k)) & 1u) { __syncthreads(); call; } } } while (0)
    RUN(0, phase_prep(p, F)); SEAM(0);
    RUN(1, phase_inproj(p, F)); SEAM(1);
    RUN(2, phase_mixA(p, F)); SEAM(2);
    RUN(3, phase_mixB(p, F)); SEAM(3);
    RUN(4, phase_outproj(p, F)); SEAM(4);
    RUN(5, phase_route(p, F)); SEAM(5);
    RUN(6, phase_gateup(p, F)); SEAM(6);
    RUN(7, phase_down(p, F)); SEAM(7);
    RUN(8, phase_final(p, F));
#undef RUN
#undef IN
#undef SEAM
}

extern "C" void kernel_launch(void* const* d_in, const int* in_sizes, int n_in, void* d_out, int out_size, void* d_ws, size_t ws_size, hipStream_t stream) {
    static int grid = 0;
    if (grid == 0) {
        if (n_in != 18 || in_sizes[0] != NTOK * D || out_size != NTOK * D || ws_size < WS_END) {
            fprintf(stderr, "kernel_launch: unexpected shapes / workspace (n_in %d, in0 %d, out %d, ws %zu, need %zu); nothing launched\n", n_in, n_in > 0 ? in_sizes[0] : -1, out_size, ws_size, (size_t)WS_END);
            grid = -1; return; }
        int dev = 0, cus = 0;
        if (hipGetDevice(&dev) != hipSuccess || hipDeviceGetAttribute(&cus, hipDeviceAttributeMultiprocessorCount, dev) != hipSuccess) { grid = -1; return; }
        if (hipFuncSetAttribute((const void*)fwd, hipFuncAttributeMaxDynamicSharedMemorySize, LDS_BYTES) != hipSuccess) { fprintf(stderr, "kernel_launch: hipFuncSetAttribute failed\n"); grid = -1; return; }
        int per_cu = 0;
        if (hipOccupancyMaxActiveBlocksPerMultiprocessor(&per_cu, (const void*)fwd, NTHREADS, LDS_BYTES) != hipSuccess || per_cu < 1) fprintf(stderr, "kernel_launch: occupancy query says %d\n", per_cu);
        (void)hipGetLastError();
        grid = cus;
    }
    if (grid < 0) return;
    (void)hipMemsetAsync((char*)d_ws + WS_CTL, 0, CTL_ZERO_BYTES, stream);
    Params p{};
    p.x = (const float*)d_in[0]; p.norm1_g = (const float*)d_in[1]; p.w_in = (const float*)d_in[2]; p.hgrn_lb = (const float*)d_in[3]; p.hgrn_norm_g = (const float*)d_in[4];
    p.pool_w = (const float*)d_in[5]; p.pool_scale = (const float*)d_in[6]; p.w_out = (const float*)d_in[7]; p.norm2_g = (const float*)d_in[8]; p.router_w = (const float*)d_in[9];
    p.router_b = (const float*)d_in[10]; p.w_gate = (const float*)d_in[11]; p.b_gate = (const float*)d_in[12]; p.w_up = (const float*)d_in[13]; p.b_up = (const float*)d_in[14];
    p.w_down = (const float*)d_in[15]; p.b_down = (const float*)d_in[16]; p.norm_f_g = (const float*)d_in[17];
    p.out = (float*)d_out; p.ws = (unsigned char*)d_ws;
#if MK_PER_PHASE
    for (int k = 0; k < N_PHASES; ++k) { p.ph_lo = k; p.ph_hi = k + 1; hipLaunchKernelGGL(fwd, dim3(grid), dim3(NTHREADS), LDS_BYTES, stream, p); }
#else
    p.ph_lo = 0; p.ph_hi = N_PHASES; hipLaunchKernelGGL(fwd, dim3(grid), dim3(NTHREADS), LDS_BYTES, stream, p);
#endif
}
```
